# Optimizing an MI355X kernel written in HIP

```python
import jax
import jax.numpy as jnp
from jax import lax
import numpy as np

D_MODEL = 2048
BATCH = 8
SEQ = 2048
DEPTH = 1

HG_HEADS = 8
HG_DK = 128
HG_DV = 128
HG_FDIM = HG_HEADS * HG_DK
HG_VDIM = HG_HEADS * HG_DV

GLA_HEADS = 4
GLA_DK = 128
GLA_DV = 256
GLA_KDIM = GLA_HEADS * GLA_DK
GLA_VDIM = GLA_HEADS * GLA_DV
GLA_GATE_RANK = 16
GLA_GATE_NORM = 16.0

CHUNK = 64

N_EXPERTS = 32
TOP_K = 4
D_FF = D_MODEL
SWIGLU_LIMIT = 7.0
SWIGLU_ALPHA = 1.702
MOE_BLOCK = 256

RMS_EPS = 1e-5

IN_SPLITS = (HG_FDIM, HG_FDIM, HG_FDIM, HG_VDIM, HG_VDIM,
             GLA_KDIM, GLA_KDIM, GLA_VDIM, GLA_VDIM, GLA_GATE_RANK, GLA_GATE_RANK,
             D_MODEL, D_MODEL)
D_IN = 3 * HG_FDIM + 2 * HG_VDIM + 2 * GLA_KDIM + 2 * GLA_VDIM + 2 * GLA_GATE_RANK + 2 * D_MODEL

kernel_name = 'hybrid_hgrn2_gla_moe_encoder'


def rms_norm(x, g):
    xf = x.astype(jnp.float32)
    y = xf * lax.rsqrt(jnp.mean(xf * xf, axis=-1, keepdims=True) + RMS_EPS)
    return (y * g.astype(jnp.float32)).astype(x.dtype)


def split_points():
    pts, acc = [], 0
    for w in IN_SPLITS[:-1]:
        acc += w
        pts.append(acc)
    return pts


def heads(a, n):
    return a.reshape(a.shape[0], a.shape[1], n, -1)


def chunk_gated_recurrence(q, k, v, log_g):
    B, T, H, dk = q.shape
    dv = v.shape[-1]
    n_chunks = T // CHUNK

    def to_chunks(a):
        return a.astype(jnp.float32).reshape(B, n_chunks, CHUNK, H, a.shape[-1]).transpose(1, 0, 3, 2, 4)

    qc, kc, vc = to_chunks(q), to_chunks(k), to_chunks(v)
    bc = jnp.cumsum(to_chunks(log_g), axis=-2)
    causal = jnp.tril(jnp.ones((CHUNK, CHUNK), dtype=bool))[:, :, None]

    def step(state, inp):
        qi, ki, vi, bi = inp
        b_last = bi[..., -1:, :]
        diff = bi[..., :, None, :] - bi[..., None, :, :]
        decay = jnp.exp(jnp.where(causal, diff, -jnp.inf))
        scores = jnp.einsum('bhtk,bhsk,bhtsk->bhts', qi, ki, decay)
        o = (jnp.einsum('bhts,bhsv->bhtv', scores, vi)
             + jnp.einsum('bhtk,bhkv->bhtv', qi * jnp.exp(bi), state))
        state = (state * jnp.exp(b_last)[..., 0, :, None]
                 + jnp.einsum('bhsk,bhsv->bhkv', ki * jnp.exp(b_last - bi), vi))
        return state, o

    state0 = jnp.zeros((B, H, dk, dv), jnp.float32)
    _, o = lax.scan(step, state0, (qc, kc, vc, bc))
    return o.transpose(1, 0, 3, 2, 4).reshape(B, T, H, dv).astype(v.dtype)


def bidirectional_recurrence(q, v, k_fwd, g_fwd, k_bwd, g_bwd):
    flip = lambda a: jnp.flip(a, axis=1)
    fwd = chunk_gated_recurrence(q, k_fwd, v, g_fwd)
    bwd = flip(chunk_gated_recurrence(flip(q), flip(k_bwd), flip(v), flip(g_bwd)))
    return fwd + bwd


def hgrn_lower_bound(lb_logits, layer):
    p = jax.nn.softmax(lb_logits.astype(jnp.float32), axis=1)
    return jnp.cumsum(p, axis=1)[:, layer]


def mixer_block(xn, w_in, lb, hg_norm_g, gla_gate_w2, gla_gate_b, gla_norm_g, w_proj_a, w_proj_b, w_out):
    B, T, _ = xn.shape
    z = xn @ w_in
    (hq, hf_fwd, hf_bwd, hi, hog, gq, gk, gv, gr,
     glr_fwd, glr_bwd, mg_a, mg_b) = jnp.split(z, split_points(), axis=-1)

    q_a = heads(jax.nn.silu(hq), HG_HEADS) * (HG_DK ** -0.5)
    v_a = heads(hi, HG_HEADS)

    def hg_gates(f_pre, lb_d):
        f = lb_d + (1.0 - lb_d) * jax.nn.sigmoid(f_pre.astype(jnp.float32))
        return heads(1.0 - f, HG_HEADS), heads(jnp.log(f), HG_HEADS)

    k_af, g_af = hg_gates(hf_fwd, lb[0])
    k_ab, g_ab = hg_gates(hf_bwd, lb[1])
    o_a = bidirectional_recurrence(q_a, v_a, k_af, g_af, k_ab, g_ab).astype(xn.dtype)
    o_a = rms_norm(o_a, hg_norm_g) * jax.nn.silu(heads(hog, HG_HEADS))
    y_a = o_a.reshape(B, T, HG_VDIM) @ w_proj_a

    q_b = heads(gq, GLA_HEADS) * (GLA_DK ** -0.5)
    k_b = heads(gk, GLA_HEADS)
    v_b = heads(gv, GLA_HEADS)

    def gla_log_gate(lr, d):
        logits = (lr @ gla_gate_w2[d] + gla_gate_b[d]).astype(jnp.float32)
        return heads(jax.nn.log_sigmoid(logits) / GLA_GATE_NORM, GLA_HEADS)

    o_b = bidirectional_recurrence(q_b, v_b, k_b, gla_log_gate(glr_fwd, 0),
                                   k_b, gla_log_gate(glr_bwd, 1)).astype(xn.dtype)
    o_b = rms_norm(o_b, gla_norm_g) * jax.nn.silu(heads(gr, GLA_HEADS))
    y_b = o_b.reshape(B, T, GLA_VDIM) @ w_proj_b

    merged = jax.nn.sigmoid(mg_a) * y_a + jax.nn.sigmoid(mg_b) * y_b
    return merged @ w_out


def moe_block(hn, router_w, router_b, w_gate_up, b_gate_up, w_down, b_down):
    B, T, D = hn.shape
    n_tok = B * T
    n_pairs = n_tok * TOP_K
    xt = hn.reshape(n_tok, D)
    logits = (xt @ router_w).astype(jnp.float32) + router_b.astype(jnp.float32)
    top_val, top_idx = lax.top_k(logits, TOP_K)
    probs = jax.nn.softmax(top_val, axis=-1)

    pair_e = top_idx.reshape(-1).astype(jnp.int32)
    pair_tok = jnp.repeat(jnp.arange(n_tok, dtype=jnp.int32), TOP_K)
    pair_w = probs.reshape(-1)
    order = jnp.argsort(pair_e)
    se, st, sw = pair_e[order], pair_tok[order], pair_w[order]

    counts = jnp.bincount(pair_e, length=N_EXPERTS)
    padded = (counts + MOE_BLOCK - 1) // MOE_BLOCK * MOE_BLOCK
    pad_end = jnp.cumsum(padded)
    pad_start = pad_end - padded
    grp_start = jnp.cumsum(counts) - counts
    dest = pad_start[se] + jnp.arange(n_pairs, dtype=jnp.int32) - grp_start[se]
    n_blocks = -(-n_pairs // MOE_BLOCK) + N_EXPERTS
    n_rows = n_blocks * MOE_BLOCK
    row_tok = jnp.zeros((n_rows,), jnp.int32).at[dest].set(st)
    row_w = jnp.zeros((n_rows,), jnp.float32).at[dest].set(sw)
    block_start = jnp.arange(n_blocks, dtype=jnp.int32) * MOE_BLOCK
    block_e = jnp.minimum(jnp.searchsorted(pad_end, block_start, side='right'), N_EXPERTS - 1)

    def run_block(args):
        e, tok = args
        xb = xt[tok]
        gu = xb @ w_gate_up[e] + b_gate_up[e]
        gate = jnp.minimum(gu[:, ::2], SWIGLU_LIMIT)
        up = jnp.clip(gu[:, 1::2], -SWIGLU_LIMIT, SWIGLU_LIMIT)
        act = (up + 1.0) * (gate * jax.nn.sigmoid(SWIGLU_ALPHA * gate))
        return act @ w_down[e] + b_down[e]

    outs = lax.map(run_block, (block_e, row_tok.reshape(n_blocks, MOE_BLOCK)))
    outs = outs.reshape(n_rows, D) * row_w[:, None].astype(outs.dtype)
    y = jax.ops.segment_sum(outs, row_tok, num_segments=n_tok)
    return y.reshape(B, T, D)


def setup_inputs(seed: int = 0) -> dict:
    key = jax.random.key(seed)
    ks = jax.random.split(key, 20)
    f32 = jnp.float32
    L = DEPTH

    def nrm(k, shape, scale):
        return jax.random.normal(k, shape, f32) * scale

    return {
        'x': nrm(ks[0], (BATCH, SEQ, D_MODEL), 1.0),
        'norm1_g': 1.0 + nrm(ks[1], (L, D_MODEL), 0.02),
        'w_in': nrm(ks[2], (L, D_MODEL, D_IN), D_MODEL ** -0.5),
        'hg_lb_logits': nrm(ks[3], (2, L + 1, HG_FDIM), 0.5),
        'hg_norm_g': 1.0 + nrm(ks[4], (L, HG_DV), 0.02),
        'gla_gate_w2': nrm(ks[5], (L, 2, GLA_GATE_RANK, GLA_KDIM), GLA_GATE_RANK ** -0.5),
        'gla_gate_b': nrm(ks[6], (L, 2, GLA_KDIM), 0.1),
        'gla_norm_g': 1.0 + nrm(ks[7], (L, GLA_DV), 0.02),
        'w_proj_a': nrm(ks[8], (L, HG_VDIM, D_MODEL), HG_VDIM ** -0.5),
        'w_proj_b': nrm(ks[9], (L, GLA_VDIM, D_MODEL), GLA_VDIM ** -0.5),
        'w_out': nrm(ks[10], (L, D_MODEL, D_MODEL), D_MODEL ** -0.5),
        'norm2_g': 1.0 + nrm(ks[11], (L, D_MODEL), 0.02),
        'router_w': nrm(ks[12], (L, D_MODEL, N_EXPERTS), D_MODEL ** -0.5),
        'router_b': nrm(ks[13], (L, N_EXPERTS), 0.01),
        'w_gate_up': nrm(ks[14], (L, N_EXPERTS, D_MODEL, 2 * D_FF), D_MODEL ** -0.5),
        'b_gate_up': nrm(ks[15], (L, N_EXPERTS, 2 * D_FF), 0.02),
        'w_down': nrm(ks[16], (L, N_EXPERTS, D_FF, D_MODEL), D_FF ** -0.5),
        'b_down': nrm(ks[17], (L, N_EXPERTS, D_MODEL), 0.02),
        'final_norm_g': 1.0 + nrm(ks[18], (D_MODEL,), 0.02),
    }


def reference(x, norm1_g, w_in, hg_lb_logits, hg_norm_g, gla_gate_w2, gla_gate_b, gla_norm_g,
              w_proj_a, w_proj_b, w_out, norm2_g, router_w, router_b, w_gate_up, b_gate_up,
              w_down, b_down, final_norm_g):
    h = x
    for layer in range(DEPTH):
        lb = hgrn_lower_bound(hg_lb_logits, layer)
        h = h + mixer_block(rms_norm(h, norm1_g[layer]), w_in[layer], lb, hg_norm_g[layer],
                            gla_gate_w2[layer], gla_gate_b[layer], gla_norm_g[layer],
                            w_proj_a[layer], w_proj_b[layer], w_out[layer])
        h = h + moe_block(rms_norm(h, norm2_g[layer]), router_w[layer], router_b[layer],
                          w_gate_up[layer], b_gate_up[layer], w_down[layer], b_down[layer])
    return rms_norm(h, final_norm_g)
```

```cpp
#include <hip/hip_runtime.h>
#include <stdint.h>
#define LAS __attribute__((address_space(3)))
#define GAS __attribute__((address_space(1)))
typedef unsigned short bf16_t;
typedef short bf16x8 __attribute__((ext_vector_type(8)));
typedef float f32x4 __attribute__((ext_vector_type(4)));
typedef float f32x2 __attribute__((ext_vector_type(2)));
typedef unsigned u32x4 __attribute__((ext_vector_type(4)));
typedef unsigned u32x2 __attribute__((ext_vector_type(2)));

typedef __bf16 bf16x2_t __attribute__((ext_vector_type(2)));
__device__ __forceinline__ unsigned cvt_pk_bf16(float lo, float hi) { const f32x2 v = {lo, hi}; const bf16x2_t b = __builtin_convertvector(v, bf16x2_t); return __builtin_bit_cast(unsigned, b); }
__device__ __forceinline__ unsigned pk2(float lo, float hi) { return cvt_pk_bf16(lo, hi); }
__device__ __forceinline__ unsigned f2bf(float f) { return cvt_pk_bf16(f, 0.f) & 0xffffu; }
__device__ __forceinline__ float bf_lo(unsigned w) { return __builtin_bit_cast(float, w << 16); }
__device__ __forceinline__ float bf_hi(unsigned w) { return __builtin_bit_cast(float, w & 0xffff0000u); }
__device__ __forceinline__ float fsigm(float x) { return __builtin_amdgcn_rcpf(1.f + __expf(-x)); }
__device__ __forceinline__ float wave_sum(float v) {
#pragma unroll
    for (int o = 1; o < 64; o <<= 1) v += __shfl_xor(v, o);
    return v;
}

#define XB_TMO      128
#define XB_XCNT(j)  (256  + 64 * (j))
#define XB_XSUB(j)  (1280 + 64 * (j))
#define XB_XGEN(j)  (2304 + 64 * (j))
#define XB_TOP      3328
#define XB_TOPGEN   3392
#define XCD_BAR_WORDS 3456
#define XB_SPIN_CAP (1u << 18)
__device__ __forceinline__ unsigned xb_ld(unsigned* p)              { return __hip_atomic_load(p, __ATOMIC_RELAXED, __HIP_MEMORY_SCOPE_AGENT); }
__device__ __forceinline__ unsigned xb_add(unsigned* p, unsigned v) { return __hip_atomic_fetch_add(p, v, __ATOMIC_RELAXED, __HIP_MEMORY_SCOPE_AGENT); }
__device__ __forceinline__ unsigned xb_xcc_id() { return (unsigned)__builtin_amdgcn_s_getreg((3 << 11) | 20) & 0xFu; }
#define XB_SPIN(cond, bar) do { unsigned _sp = 0; while (cond) { __builtin_amdgcn_s_sleep(1); \
    if ((++_sp & 255u) == 0u) { if (xb_ld(&(bar)[XB_TMO])) break; if (_sp > XB_SPIN_CAP) { atomicAdd(&(bar)[XB_TMO], 1u); break; } } } } while (0)
struct XcdBarrier { unsigned* bar; unsigned x; volatile LAS unsigned* st; };
__device__ __forceinline__ XcdBarrier xcd_barrier_post(unsigned* bar, volatile LAS unsigned* st) {
    XcdBarrier b; b.bar = bar; b.x = xb_xcc_id(); b.st = st;
    if (threadIdx.x == 0) (void)xb_add(&bar[XB_XCNT(b.x)], 1u);
    return b;
}
__device__ __forceinline__ void xcd_barrier_complete(unsigned* bar, unsigned x, unsigned& nloc, unsigned& nx) {
    const unsigned G = gridDim.x * gridDim.y * gridDim.z;
    unsigned sum, cnt, mine, sp = 0u;
    for (;;) {
        sum = 0u; cnt = 0u; mine = 0u;
#pragma unroll
        for (unsigned j = 0; j < 16; ++j) { const unsigned c = xb_ld(&bar[XB_XCNT(j)]); sum += c; cnt += (c > 0u) ? 1u : 0u; mine = (j == x) ? c : mine; }
        if (sum == G) break;
        __builtin_amdgcn_s_sleep(1);
        if ((++sp & 255u) == 0u) { if (xb_ld(&bar[XB_TMO])) break; if (sp > XB_SPIN_CAP) { atomicAdd(&bar[XB_TMO], 1u); break; } }
    }
    nloc = mine > 0u ? mine : 1u; nx = cnt > 0u ? cnt : 1u;
}
__device__ __forceinline__ void xcd_barrier(const XcdBarrier& b) {
    asm volatile("s_waitcnt vmcnt(0)" ::: "memory");
    __syncthreads();
    if (threadIdx.x == 0) {
        unsigned* bar = b.bar;
        __builtin_amdgcn_s_waitcnt(0);
        unsigned nloc = b.st[0], nx = b.st[1];
        if (nloc == 0u) { xcd_barrier_complete(bar, b.x, nloc, nx); b.st[0] = nloc; b.st[1] = nx; }
        const unsigned old = xb_add(&bar[XB_XSUB(b.x)], 1u);
        const unsigned gen = old / nloc;
        if (old + 1u == (gen + 1u) * nloc) {
            __builtin_amdgcn_fence(__ATOMIC_RELEASE, "agent");
            asm volatile("s_waitcnt vmcnt(0)" ::: "memory");
            const unsigned og = xb_add(&bar[XB_TOP], 1u);
            const unsigned tg = og / nx;
            if (og + 1u == (tg + 1u) * nx) xb_add(&bar[XB_TOPGEN], 1u);
            else XB_SPIN(xb_ld(&bar[XB_TOPGEN]) == tg, bar);
            __builtin_amdgcn_fence(__ATOMIC_ACQUIRE, "agent");
            xb_add(&bar[XB_XGEN(b.x)], 1u);
            asm volatile("s_waitcnt vmcnt(0)" ::: "memory");
        } else {
            XB_SPIN(xb_ld(&bar[XB_XGEN(b.x)]) == gen, bar);
            __builtin_amdgcn_fence(__ATOMIC_ACQUIRE, "agent");
            asm volatile("s_waitcnt vmcnt(0)" ::: "memory");
        }
    }
    __syncthreads();
}

#ifndef MK_FILL_HOOK
#define MK_FILL_HOOK 0
#endif
#ifndef MK_EPI_RELAX
#define MK_EPI_RELAX 62
#endif
#ifndef MK_BF_ASM
#define MK_BF_ASM 0
#endif
#ifndef MK_BF_LASTPEEL
#define MK_BF_LASTPEEL 0
#endif
#ifndef MK_PRE_EARLY
#define MK_PRE_EARLY 3
#endif
#ifndef MK_EPI_PRESTAGE
#define MK_EPI_PRESTAGE 0
#endif
#ifndef MK_FILL_EARLY
#define MK_FILL_EARLY 0
#endif
#ifndef MK_FILL_ASM
#define MK_FILL_ASM ((MK_FILL_EARLY || MK_EPI_RELAX) ? 1 : 0)
#endif
#ifndef MK_TID_LAUNDER
#define MK_TID_LAUNDER 0
#endif
namespace pg8 {
constexpr int BM = 256, BK = 64, HALF = 128, HTB = HALF * BK * 2, STAGE_BYTES = 8 * HTB, NXCD = 8, WGM = 8;
__device__ __forceinline__ int lds_byte(int r, int c) { const int st = (r >> 4) * 2 + (c >> 5), rr = r & 15, cc = c & 31, ob = rr * 64 + cc * 2; return st * 1024 + (ob ^ (((ob >> 9) & 1) << 5)); }
__device__ __forceinline__ void stage_rc(int b, int& R, int& C) { const int st = b / 1024, sb = b % 1024, swz = sb ^ (((sb >> 9) & 1) << 5); R = (st >> 1) * 16 + swz / 64; C = (st & 1) * 32 + (swz % 64) / 2; }
__device__ __forceinline__ int perm32(int rho) { const int n = rho >> 4, i = rho & 15; return 8 * (i >> 2) + 4 * n + (i & 3); }

template <bool B> struct BoolC { static constexpr bool value = B; };
struct Unit { int pm, pn, aux, r0, half; };

__device__ __forceinline__ bool static_next(int nM, int nN, int G, int c, int i, int& pm, int& pn) {
    const int nwg = nM * nN; const long L = (long)i * G + c; if (L >= nwg) return false;
    int wgid = (int)L; { const int q = nwg / NXCD, r = nwg % NXCD, xcd = wgid % NXCD, off = wgid / NXCD; wgid = (xcd < r ? xcd * (q + 1) : r * (q + 1) + (xcd - r) * q) + off; }
    const int nig = WGM * nN, gid = wgid / nig, fm = gid * WGM, gsz = (nM - fm) < WGM ? (nM - fm) : WGM;
    pm = fm + ((wgid % nig) % gsz); pn = (wgid % nig) / gsz; return true;
}
__device__ __forceinline__ int xcd_remap(int L, int nwg) { const int q = nwg / NXCD, r = nwg % NXCD, xcd = L % NXCD, off = L / NXCD; return (xcd < r ? xcd * (q + 1) : r * (q + 1) + (xcd - r) * q) + off; }

typedef int v8i_t __attribute__((ext_vector_type(8)));
struct NoFill { static constexpr bool ON = false; static constexpr int NL = 2, NS = 0; template <int LO, int HI> __device__ __forceinline__ void issue_part(f32x4 (&)[2], int) const {} __device__ __forceinline__ void issue(f32x4 (&)[2], int) const {} __device__ __forceinline__ void consume(f32x4 (&)[2], int) const {} };
struct NoKFill { static constexpr bool ON = false; static constexpr int NL = 1, NS = 0; __device__ __forceinline__ void issue(f32x4 (&)[1], int) const {} __device__ __forceinline__ void consume(f32x4 (&)[1], int) const {} };
template <class Epi, class Sched, bool FP8 = false, class Fill = NoFill, class KF = NoKFill, bool HALFCAP = false, bool RELAX = false>
__device__ __forceinline__ int gemm_phase(LAS unsigned char* lds, const int RB, Sched& S, const Epi& E, const Fill& FL = Fill(), const KF& KFL = KF()) {
    int tid_ = threadIdx.x;
    if constexpr ((MK_TID_LAUNDER != 0) || (RELAX && !FP8)) asm volatile("" : "+v"(tid_));
    const int tid = tid_, wid = __builtin_amdgcn_readfirstlane(tid >> 6), lane = tid & 63, wr = wid >> 2, wc = wid & 3, fr = lane & 15, fq = lane >> 4;
    const int nt = RB / 128;
    int Rr[2], Cc[2]; unsigned voffB[2];
#pragma unroll
    for (int i = 0; i < 2; ++i) { int R, C; stage_rc(tid * 16 + i * 8192, R, C); Rr[i] = R; Cc[i] = C; const int Rb = Epi::brow(R); voffB[i] = (unsigned)(Rb * RB + C * 2); }
    const size_t kstep = (size_t)(BK * 2);
    const size_t hstep = (size_t)Epi::BHALF_ROWS * RB;
    const unsigned ldsw = (unsigned)wid * 1024u, ldsb = (unsigned)(size_t)lds;
    const int aoff = lds_byte(wr * 64 + fr, fq * 8), boff = lds_byte(wc * 32 + fr, fq * 8);
#define PG8_SA(b, h) (((b) * 2 + (h)) * HTB)
#define PG8_SB(b, h) ((4 + (b) * 2 + (h)) * HTB)
#define PG8_STAGE(bufoff, gbase, v0, v1) do { unsigned keep_; \
        asm volatile("s_mov_b32 %0, m0\n\ts_mov_b32 m0, %4\n\ts_nop 0\n\tglobal_load_lds_dwordx4 %1, %3\n\ts_add_u32 m0, m0, 0x2000\n\ts_nop 0\n\tglobal_load_lds_dwordx4 %2, %3\n\ts_mov_b32 m0, %0" \
            : "=&s"(keep_) : "v"(v0), "v"(v1), "s"((const char*)(gbase)), "s"(ldsb + (unsigned)(bufoff) + ldsw) : "memory", "scc"); } while (0)
#define PG8_STAGEB(bufoff, gbase) PG8_STAGE(bufoff, gbase, voffB[0], voffB[1])
#define PG8_LD8(addr) __builtin_shufflevector(*(const LAS u32x4*)(addr), *(const LAS u32x4*)((addr) + 1024), 0, 1, 2, 3, 4, 5, 6, 7)
#define PG8_LDA(dst, b, h) do { _Pragma("unroll") for (int m = 0; m < 4; ++m) dst[m] = PG8_LD8(lds + PG8_SA(b, h) + aoff + m * 2048); } while (0)
#define PG8_LDB(dst, b, h) do { _Pragma("unroll") for (int n = 0; n < 2; ++n) dst[n] = PG8_LD8(lds + PG8_SB(b, h) + boff + n * 2048); } while (0)
#define PG8_HALF(x, k) __builtin_bit_cast(bf16x8, __builtin_shufflevector(x, x, 4 * (k), 4 * (k) + 1, 4 * (k) + 2, 4 * (k) + 3))
#define PG8_MMA(ai, bj, At, Bt) do { __builtin_amdgcn_s_setprio(1); \
        if constexpr (!FP8 && (MK_BF_ASM != 0)) { _Pragma("unroll") for (int k_ = 0; k_ < 2; ++k_) _Pragma("unroll") for (int m = 0; m < 4; ++m) _Pragma("unroll") for (int n = 0; n < 2; ++n) { \
            const u32x4 b_ = k_ ? __builtin_shufflevector(Bt[n], Bt[n], 4, 5, 6, 7) : __builtin_shufflevector(Bt[n], Bt[n], 0, 1, 2, 3), a_ = k_ ? __builtin_shufflevector(At[m], At[m], 4, 5, 6, 7) : __builtin_shufflevector(At[m], At[m], 0, 1, 2, 3); \
            asm volatile("v_mfma_f32_16x16x32_bf16 %0, %1, %2, %0" : "+v"(acc[ai][bj][m][n]) : "v"(b_), "v"(a_)); } } else \
        _Pragma("unroll") for (int m = 0; m < 4; ++m) _Pragma("unroll") for (int n = 0; n < 2; ++n) { \
        if constexpr (FP8) { asm volatile("v_mfma_scale_f32_16x16x128_f8f6f4 %0, %1, %2, %0, %3, %4 op_sel_hi:[0,0,0]" : "+v"(acc[ai][bj][m][n]) : "v"(Bt[n]), "v"(At[m]), "v"(sc_w), "v"(sc_1)); } \
        else { acc[ai][bj][m][n] = __builtin_amdgcn_mfma_f32_16x16x32_bf16(PG8_HALF(Bt[n], 0), PG8_HALF(At[m], 0), acc[ai][bj][m][n], 0, 0, 0); \
               acc[ai][bj][m][n] = __builtin_amdgcn_mfma_f32_16x16x32_bf16(PG8_HALF(Bt[n], 1), PG8_HALF(At[m], 1), acc[ai][bj][m][n], 0, 0, 0); } } \
        __builtin_amdgcn_s_setprio(0); } while (0)
#define PG8_WAIT_V(n) asm volatile("s_waitcnt vmcnt(" #n ")" ::: "memory")
#define PG8_WAIT_VN(N) asm volatile("s_waitcnt vmcnt(%0)" :: "n"(N) : "memory")
#define PG8_WAIT_L(n) asm volatile("s_waitcnt lgkmcnt(" #n ")" ::: "memory")
#define PG8_BAR __builtin_amdgcn_s_barrier()
#define PG8_SCHED __builtin_amdgcn_sched_barrier(0)
    Unit cur, nxt; int ui = 0;
    if (!S.next(0, cur)) return 0;
    f32x4 acc[2][2][4][2];
#pragma unroll
    for (int a = 0; a < 2; ++a)
#pragma unroll
        for (int b = 0; b < 2; ++b)
#pragma unroll
            for (int m = 0; m < 4; ++m)
#pragma unroll
                for (int n = 0; n < 2; ++n) acc[a][b][m][n] = (f32x4){0.f, 0.f, 0.f, 0.f};
    typedef unsigned u32x8 __attribute__((ext_vector_type(8)));
    u32x8 At[4], B0[2], B1[2];
    f32x4 ff[Fill::NL];
    constexpr bool LP = (RELAX && (FP8 || (MK_BF_ASM != 0)) && (MK_PRE_EARLY != 0)) || ((MK_BF_LASTPEEL != 0) && !FP8 && !RELAX && Fill::ON && !KF::ON);
    constexpr bool PRE = RELAX && (MK_EPI_PRESTAGE != 0);
    constexpr int EA_ = (Fill::ON ? Fill::NL + Fill::NS : 0) + Epi::VM_MIN, EA = EA_ > 55 ? 55 : EA_;
    f32x4 kf[KF::NL]; int kfi = 0;
    const unsigned sc_w = 0x77777777u, sc_1 = 0x7f7f7f7fu;
    if (Sched::GATHER) { S.pre(cur, 0); PG8_WAIT_V(0); __syncthreads(); }
    unsigned vc[2][2];
    S.a_voff(cur, 0, vc, Rr, Cc, RB);
    const char* cA = S.a_base(cur); const char* cB = S.b_base(cur);
    PG8_STAGEB(PG8_SB(0, 0), cB); PG8_STAGEB(PG8_SB(0, 1), cB + hstep); PG8_STAGE(PG8_SA(0, 0), cA, vc[0][0], vc[0][1]); PG8_STAGE(PG8_SA(0, 1), cA, vc[1][0], vc[1][1]);
    if (wr == 1) PG8_BAR;
    PG8_WAIT_V(2); PG8_BAR;
    PG8_STAGEB(PG8_SB(1, 0), cB + kstep); PG8_STAGE(PG8_SA(1, 0), cA + kstep, vc[0][0], vc[0][1]); PG8_STAGEB(PG8_SB(1, 1), cB + hstep + kstep);
    if constexpr (PRE) PG8_STAGE(PG8_SA(1, 1), cA + kstep, vc[1][0], vc[1][1]);
    if constexpr (KF::ON || RELAX) PG8_WAIT_V(0); else PG8_WAIT_V(6);
    PG8_BAR;
    for (;;) {
        const bool has_next = S.next(ui + 1, nxt);
        const bool hf = HALFCAP && cur.half != 0;
        const char* nA = has_next ? S.a_base(nxt) : cA; const char* nB = has_next ? S.b_base(nxt) : cB;
#define PG8_KITER(T_, FE_, LE_) do { const int t = (T_); \
            const bool last = (t == nt - 2); \
            constexpr bool fe = RELAX && !KF::ON && (FE_); \
            if (Sched::GATHER) { if (t == nt - 4 && has_next) S.pre(nxt, ui + 1); } \
            unsigned vs[2][2]; \
_Pragma("unroll") \
            for (int h = 0; h < 2; ++h) \
_Pragma("unroll") \
                for (int i = 0; i < 2; ++i) vs[h][i] = vc[h][i]; \
            if (Sched::GATHER) { if (last && has_next) S.a_voff(nxt, ui + 1, vs, Rr, Cc, RB); } \
            const char* a1 = cA + (size_t)(t + 1) * kstep; \
            const char* a2 = last ? nA : cA + (size_t)(t + 2) * kstep; const char* b2 = last ? nB : cB + (size_t)(t + 2) * kstep; \
            const char* a3 = a2 + kstep; const char* b3 = b2 + kstep; \
            PG8_LDB(B0, 0, 0); PG8_LDB(B1, 0, 1); PG8_SCHED; PG8_LDA(At, 0, 0); if constexpr (!(fe && PRE)) PG8_STAGE(PG8_SA(1, 1), a1, vc[1][0], vc[1][1]); \
            if constexpr (fe) PG8_WAIT_VN(8 + EA); else PG8_WAIT_VN(8 + KF::NS); \
            PG8_WAIT_L(0); PG8_BAR; if constexpr (KF::ON) KFL.issue(kf, kfi); PG8_MMA(0, 0, At, B0); PG8_MMA(0, 1, At, B1); PG8_BAR; PG8_SCHED; \
            if (!hf) PG8_LDA(At, 0, 1); PG8_STAGEB(PG8_SB(0, 0), b2); PG8_STAGEB(PG8_SB(0, 1), b2 + hstep); PG8_STAGE(PG8_SA(0, 0), a2, vs[0][0], vs[0][1]); \
            if constexpr (fe) PG8_WAIT_VN(8 + EA); else PG8_WAIT_VN(8 + KF::NS + (KF::ON ? KF::NL : 0)); \
            PG8_WAIT_L(0); PG8_BAR; if (!hf) { PG8_MMA(1, 0, At, B0); PG8_MMA(1, 1, At, B1); } PG8_BAR; PG8_SCHED; \
            PG8_LDB(B0, 1, 0); PG8_LDB(B1, 1, 1); PG8_SCHED; PG8_LDA(At, 1, 0); PG8_STAGE(PG8_SA(0, 1), a2, vs[1][0], vs[1][1]); \
            if constexpr (fe && PRE) PG8_WAIT_VN(8 + EA); else PG8_WAIT_VN(8 + (KF::ON ? KF::NL : 0)); \
            PG8_WAIT_L(0); PG8_BAR; PG8_MMA(0, 0, At, B0); PG8_MMA(0, 1, At, B1); PG8_BAR; PG8_SCHED; \
            if (!hf) PG8_LDA(At, 1, 1); PG8_STAGEB(PG8_SB(1, 0), b3); PG8_STAGEB(PG8_SB(1, 1), b3 + hstep); PG8_STAGE(PG8_SA(1, 0), a3, vs[0][0], vs[0][1]); \
            if constexpr (KF::ON) { static_assert(KF::NL == 4, "kf tie"); asm volatile("s_waitcnt vmcnt(8)" : "+v"(kf[0]), "+v"(kf[1]), "+v"(kf[2]), "+v"(kf[3]) :: "memory"); } else PG8_WAIT_V(8); \
            PG8_WAIT_L(0); PG8_BAR; if constexpr (LP && (LE_)) { E.preload(epre, cur, wc, fq); if constexpr (Fill::ON && (MK_PRE_EARLY >= 2)) FL.template issue_part<0, (MK_PRE_EARLY == 2 ? Fill::NL : Fill::NL / 2)>(ff, ui); } \
            if (!hf) PG8_MMA(1, 0, At, B0); if constexpr (KF::ON) { KFL.consume(kf, kfi); ++kfi; } \
            if constexpr (LP && (LE_) && Fill::ON && (MK_PRE_EARLY == 4)) FL.template issue_part<Fill::NL / 2, Fill::NL>(ff, ui); \
            if (!hf) PG8_MMA(1, 1, At, B1); PG8_BAR; PG8_SCHED; \
            if (Sched::GATHER) { if (last) { \
_Pragma("unroll") \
                for (int h = 0; h < 2; ++h) \
_Pragma("unroll") \
                    for (int i = 0; i < 2; ++i) vc[h][i] = vs[h][i]; } } \
        } while (0)
        typename Epi::Pre epre;
        if constexpr (LP && !RELAX) { for (int t_ = 0; t_ < nt - 2; t_ += 2) PG8_KITER(t_, false, false); PG8_KITER(nt - 2, false, true); }
        else if constexpr (LP) { PG8_KITER(0, true, false); for (int t_ = 2; t_ < nt - 2; t_ += 2) PG8_KITER(t_, false, false); PG8_KITER(nt - 2, false, true); }
        else if constexpr (RELAX) { PG8_KITER(0, true, false); for (int t_ = 2; t_ < nt; t_ += 2) PG8_KITER(t_, false, false); }
        else { for (int t_ = 0; t_ < nt; t_ += 2) PG8_KITER(t_, false, false); }
#undef PG8_KITER
        if (wr == 0) PG8_BAR;
        if constexpr (PRE) { if (has_next) PG8_STAGE(PG8_SA(1, 1), nA + kstep, vc[1][0], vc[1][1]); }
        if constexpr (FP8 || (MK_BF_ASM != 0)) asm volatile("s_nop 15\n\ts_nop 15\n\ts_nop 15\n\ts_nop 15" ::: "memory");
        if constexpr (!LP) E.preload(epre, cur, wc, fq);
        if constexpr (Fill::ON && LP && (MK_PRE_EARLY == 3)) FL.template issue_part<Fill::NL / 2, Fill::NL>(ff, ui);
        else if constexpr (Fill::ON && !(LP && (MK_PRE_EARLY == 2 || MK_PRE_EARLY == 4))) FL.issue(ff, ui);
        epre.template ready<(Fill::ON && (MK_FILL_ASM != 0)) ? Fill::NL : 0>();
        const bool keep = E(acc, cur, wr, wc, fr, fq, epre);
#if MK_FILL_ASM
        if constexpr (Fill::ON) FL.template consume_w<Epi::VM_MIN>(ff, ui);
#else
        if constexpr (Fill::ON) FL.consume(ff, ui);
#endif
        if (!has_next) break;
        if (!keep) {
#pragma unroll
            for (int a = 0; a < 2; ++a)
#pragma unroll
                for (int b = 0; b < 2; ++b)
#pragma unroll
                    for (int m = 0; m < 4; ++m)
#pragma unroll
                        for (int n = 0; n < 2; ++n) acc[a][b][m][n] = (f32x4){0.f, 0.f, 0.f, 0.f};
        }
        cur = nxt; cA = nA; cB = nB; ++ui;
        if (wr == 1) PG8_BAR;
    }
    PG8_WAIT_V(0);
    PG8_BAR;
    return kfi;
#undef PG8_SA
#undef PG8_SB
#undef PG8_STAGE
#undef PG8_STAGEB
#undef PG8_LDA
#undef PG8_LDB
#undef PG8_MMA
#undef PG8_HALF
#undef PG8_LD8
#undef PG8_WAIT_V
#undef PG8_WAIT_VN
#undef PG8_WAIT_L
#undef PG8_BAR
#undef PG8_SCHED
}
}

constexpr int D = 2048, NTOK = 16384, TSEQ = 2048, NBATCH = 8, DIN = 12320, NE = 32, NZ = 12288;
constexpr int Z_HQ = 0, Z_HFF = 1024, Z_HFB = 2048, Z_HI = 3072, Z_HOG = 4096, Z_GQ = 5120, Z_GK = 5632, Z_GV = 6144, Z_GR = 7168, Z_MGA = 8192, Z_MGB = 10240;
constexpr float RMS_EPS = 1e-5f, QSCALE = 0.08838834764831845f;
constexpr int NWAVES = 8, NTHREADS = 512;
#ifndef MK_FP8
#define MK_FP8 1
#endif
constexpr int MOE_RB = MK_FP8 ? D : 2 * D;
#ifndef MK_GU_IN_P2
#define MK_GU_IN_P2 1
#endif
#ifndef MK_GU_KFILL
#define MK_GU_KFILL 0
#endif
#if MK_GU_KFILL
#undef MK_GU_IN_P2
#define MK_GU_IN_P2 0
#endif
#ifndef MK_GU_SPLIT
#define MK_GU_SPLIT 16
#endif
#ifndef MK_GU_PROBE
#define MK_GU_PROBE 0
#endif
#ifndef MK_GU_P2_SKIP
#define MK_GU_P2_SKIP 0
#endif
#ifndef MK_FP8_MG
#define MK_FP8_MG 1
#endif
constexpr size_t MiB = 1u << 20;
constexpr size_t WS_CTL = 0, CTL_ZERO_BYTES = 1 * MiB;
constexpr size_t WS_LB = 1 * MiB, WS_W2T = 1 * MiB + 65536, WS_WLRT = 1 * MiB + 131072;
constexpr size_t WS_WINT = 2 * MiB, WS_WPAT = 50 * MiB, WS_WPBT = 54 * MiB, WS_WOUTT = 58 * MiB, WS_WGUT = 66 * MiB, WS_WDNT = 578 * MiB;
constexpr size_t WS_XN = 834 * MiB, WS_ZB = 898 * MiB, WS_GGLA = 1282 * MiB, WS_OBUF = 1314 * MiB, WS_YA = 1442 * MiB, WS_YB = 1474 * MiB, WS_MERGED = 1506 * MiB, WS_H1 = 1570 * MiB;
constexpr size_t WS_ROWTOK = 1698 * MiB, WS_ROWW = 1700 * MiB, WS_PAIR = 1702 * MiB, WS_ACT = 1704 * MiB, WS_YPAIR = 1992 * MiB, WS_OBUF2 = 2280 * MiB, WS_XN8 = 2344 * MiB, WS_END = 2408 * MiB;
#ifndef MK_FP8_PO
#define MK_FP8_PO 1
#endif
#ifndef MK_FP8_VG
#define MK_FP8_VG (MK_FP8_PO ? 0 : 1)
#endif
#if 0
#endif
#ifndef MK_G8
#define MK_G8 1
#endif
constexpr size_t WS_G8 = WS_END + 24 * MiB;
constexpr size_t WS_WINT8 = MK_FP8_VG ? WS_END : WS_WINT + 32 * MiB;
constexpr int CW_BAR = 4096, CW_ECNT = 8192;
constexpr int RING_BYTES = 131072, LDS_XB = RING_BYTES, LDS_LIST = RING_BYTES + 64, LDS_TAB = LDS_LIST + 2048, LDS_BYTES = 147456;
static_assert(LDS_TAB + 4 * (128 + 320) <= LDS_BYTES, "lds map");

struct Params { const float* in[19]; float* out; unsigned char* ws; };
struct Frame {
    LAS unsigned char* lds; int tid, lane, wave, vcu, G;
    const float *x, *norm1_g, *w_in, *lb_logits, *hg_norm_g, *gla_w2, *gla_b, *gla_norm_g, *w_proj_a, *w_proj_b, *w_out, *norm2_g, *router_w, *router_b, *w_gate_up, *b_gate_up, *w_down, *b_down, *final_g;
    float* out; unsigned char* ws; unsigned* ctl;
};
#define WSP(T, off) ((T*)(F.ws + (off)))

#ifndef MK_VG_MASK
#define MK_VG_MASK 15
#endif
__device__ __forceinline__ constexpr bool in_tile_is_f8(int t) { return t >= 32 || (MK_FP8_VG && (((MK_VG_MASK & 1) && t >= 12 && t < 16) || ((MK_VG_MASK & 2) && t >= 16 && t < 20) || ((MK_VG_MASK & 4) && t >= 24 && t < 28) || ((MK_VG_MASK & 8) && t >= 28 && t < 32))); }
__device__ __forceinline__ constexpr int in_tiles_f8() { int n = 0; for (int t = 0; t < 48; ++t) n += in_tile_is_f8(t) ? 1 : 0; return n; }
__device__ __forceinline__ int in_nth_tile(int j, bool f8) { int t = 0, k = -1;
#pragma unroll 1
    for (; t < 48; ++t) { if (in_tile_is_f8(t) == f8) { if (++k == j) break; } } return t; }
struct InSched {
    static constexpr bool GATHER = false;
    const void* A; const void* Bt; int nM, nN, G, c, RB, f8;
    __device__ __forceinline__ bool next(int i, pg8::Unit& u) const { u.aux = 0; u.r0 = 0; u.half = 0; const bool ok = pg8::static_next(nM, nN, G, c, i, u.pm, u.pn);
        if (MK_FP8_VG && MK_VG_MASK == 15) u.pn = f8 ? (u.pn < 8 ? u.pn + 12 : u.pn + 16) : (u.pn < 12 ? u.pn : u.pn + 8); else if (MK_FP8_VG) u.pn = in_nth_tile(u.pn, f8 != 0); else u.pn = f8 ? u.pn + 32 : u.pn;
        return ok; }
    __device__ __forceinline__ const char* a_base(const pg8::Unit& u) const { return (const char*)A + (size_t)u.pm * 256 * RB; }
    __device__ __forceinline__ const char* b_base(const pg8::Unit& u) const { return (const char*)Bt + (size_t)u.pn * 256 * RB; }
    __device__ __forceinline__ void a_voff(const pg8::Unit&, int, unsigned (&vo)[2][2], const int (&R)[2], const int (&C)[2], int K_) const {
#pragma unroll
        for (int h = 0; h < 2; ++h)
#pragma unroll
            for (int i = 0; i < 2; ++i) vo[h][i] = (unsigned)((h * 128 + R[i]) * K_ + C[i] * 2); }
    __device__ __forceinline__ void pre(const pg8::Unit&, int) const {}
};
struct DenseSched {
    static constexpr bool GATHER = false;
    const void* A; const void* Bt; int nM, nN, G, c, RB;
    __device__ __forceinline__ bool next(int i, pg8::Unit& u) const { u.aux = 0; u.r0 = 0; u.half = 0; return pg8::static_next(nM, nN, G, c, i, u.pm, u.pn); }
    __device__ __forceinline__ const char* a_base(const pg8::Unit& u) const { return (const char*)A + (size_t)u.pm * 256 * RB; }
    __device__ __forceinline__ const char* b_base(const pg8::Unit& u) const { return (const char*)Bt + (size_t)u.pn * 256 * RB; }
    __device__ __forceinline__ void a_voff(const pg8::Unit&, int, unsigned (&vo)[2][2], const int (&R)[2], const int (&C)[2], int K_) const {
#pragma unroll
        for (int h = 0; h < 2; ++h)
#pragma unroll
            for (int i = 0; i < 2; ++i) vo[h][i] = (unsigned)((h * 128 + R[i]) * K_ + C[i] * 2); }
    __device__ __forceinline__ void pre(const pg8::Unit&, int) const {}
};
struct MergeSched {
    static constexpr bool GATHER = false;
    const bf16_t *A0, *B0; long dA, dB; int nM, nN, G, c, RB;
    __device__ __forceinline__ bool next(int i, pg8::Unit& u) const { u.aux = i & 1; u.r0 = 0; u.half = 0; return pg8::static_next(nM, nN, G, c, i >> 1, u.pm, u.pn); }
    __device__ __forceinline__ const char* a_base(const pg8::Unit& u) const { return (const char*)A0 + (size_t)u.aux * dA + (size_t)u.pm * 256 * RB; }
    __device__ __forceinline__ const char* b_base(const pg8::Unit& u) const { return (const char*)B0 + (size_t)u.aux * dB + (size_t)u.pn * 256 * RB; }
    __device__ __forceinline__ void a_voff(const pg8::Unit&, int, unsigned (&vo)[2][2], const int (&R)[2], const int (&C)[2], int K_) const {
#pragma unroll
        for (int h = 0; h < 2; ++h)
#pragma unroll
            for (int i = 0; i < 2; ++i) vo[h][i] = (unsigned)((h * 128 + R[i]) * K_ + C[i] * 2); }
    __device__ __forceinline__ void pre(const pg8::Unit&, int) const {}
};
#ifndef MK_TAIL_SPLIT
#define MK_TAIL_SPLIT 1
#endif
#ifndef MK_HALF_TILES
#define MK_HALF_TILES 0
#endif
constexpr int TAB_NMF = 448, TAB_TBF = 480, TAB_NTF = 516, TAB_NTH = 517, TAB_HIDX = 520, TAB_EOF = 560;
static_assert(LDS_TAB + 4 * (TAB_EOF + 320) <= LDS_BYTES, "lds map (half tiles)");
__device__ __forceinline__ int tabr(const volatile LAS int* tab, int i) { return __builtin_amdgcn_readfirstlane(tab[i]); }
__device__ __forceinline__ int tab_expert_of_tile(const volatile LAS int* tab, int Tt) { return tabr(tab, 128 + Tt); }
struct GuSched {
    static constexpr bool GATHER = true;
    const void* A; const void* Bt; const int* rowtok; const volatile LAS int* tab; LAS unsigned char* lds; int G, c, RB, tid;
    __device__ __forceinline__ bool next(int i, pg8::Unit& u) const {
#if MK_HALF_TILES
        const int NTF = tabr(tab, TAB_NTF), nwgF = NTF * 16; const long L = (long)i * G + c;
        if (L < nwgF) { const int w = pg8::xcd_remap((int)L, nwgF); const int e = tabr(tab, TAB_EOF + (w >> 4));
            const int tbF = tabr(tab, TAB_TBF + e), local = w - 16 * tbF, nm = tabr(tab, TAB_NMF + e);
            u.pm = local % nm; u.pn = local / nm; u.aux = e; u.r0 = (tabr(tab, 64 + e) + u.pm) * 256; u.half = 0; return true; }
        const long Lh = L - nwgF; if (Lh >= (long)tabr(tab, TAB_NTH) * 16) return false;
        { const int e = tabr(tab, TAB_HIDX + (int)(Lh >> 4)); u.pm = tabr(tab, 32 + e) - 1; u.pn = (int)(Lh & 15); u.aux = e; u.r0 = (tabr(tab, 64 + e) + u.pm) * 256; u.half = 1; return true; }
#else
        const int NTt = tabr(tab, 100), nwg = NTt * 16; const long L = (long)i * G + c; if (L >= nwg) return false;
        const int w = pg8::xcd_remap((int)L, nwg);
        const int Tt = w >> 4; int e = tab_expert_of_tile(tab, Tt);
        const int tb = tabr(tab, 64 + e), local = w - 16 * tb, nm = tabr(tab, 32 + e);
        u.pm = local % nm; u.pn = local / nm; u.aux = e; u.r0 = (tb + u.pm) * 256; u.half = 0; return true;
#endif
    }
    __device__ __forceinline__ const char* a_base(const pg8::Unit&) const { return (const char*)A; }
    __device__ __forceinline__ const char* b_base(const pg8::Unit& u) const { return (const char*)Bt + ((size_t)u.aux * 4096 + (size_t)u.pn * 256) * RB; }
    __device__ __forceinline__ void pre(const pg8::Unit& u, int slot) const {
        if (tid < 256) __builtin_amdgcn_global_load_lds((const unsigned*)(rowtok + (size_t)u.aux * NTOK + u.pm * 256 + tid), (LAS unsigned*)(lds + LDS_LIST + (slot & 1) * 1024 + (tid >> 6) * 256), 4, 0, 0); }
    __device__ __forceinline__ void a_voff(const pg8::Unit& u, int slot, unsigned (&vo)[2][2], const int (&R)[2], const int (&C)[2], int K_) const {
        const volatile LAS int* lst = (const volatile LAS int*)(lds + LDS_LIST + (slot & 1) * 1024); const int n = tabr(tab, u.aux);
#pragma unroll
        for (int h = 0; h < 2; ++h)
#pragma unroll
            for (int i = 0; i < 2; ++i) { const int r = h * 128 + R[i]; int tok = lst[r]; if (u.pm * 256 + r >= n) tok = 0; vo[h][i] = (unsigned)(tok * K_ + C[i] * 2); } }
};
struct DownSched {
    static constexpr bool GATHER = false;
    const void* A; const void* Bt; const volatile LAS int* tab; int G, c, RB;
    __device__ __forceinline__ bool next(int i, pg8::Unit& u) const {
#if MK_HALF_TILES
        const int NTF = tabr(tab, TAB_NTF); int pf;
        if (pg8::static_next(NTF, 8, G, c, i, pf, u.pn)) { const int e = tabr(tab, TAB_EOF + pf); const int lp = pf - tabr(tab, TAB_TBF + e); u.pm = tabr(tab, 64 + e) + lp; u.aux = e; u.r0 = lp * 256; u.half = 0; return true; }
        const long Lh = (long)i * G + c - (long)NTF * 8; if (Lh < 0 || Lh >= (long)tabr(tab, TAB_NTH) * 8) return false;
        { const int e = tabr(tab, TAB_HIDX + (int)(Lh >> 3)); const int lp = tabr(tab, 32 + e) - 1; u.pm = tabr(tab, 64 + e) + lp; u.pn = (int)(Lh & 7); u.aux = e; u.r0 = lp * 256; u.half = 1; return true; }
#else
        const int NTt = tabr(tab, 100); u.half = 0;
#if MK_TAIL_SPLIT
        { const int U = NTt * 8, full = U / G, rem = U - full * G;
          if (i == full && rem > 0 && 2 * rem <= G) { if (c >= 2 * rem) return false;
              if (!pg8::static_next(NTt, 8, 1, full * G + (c >> 1), 0, u.pm, u.pn)) return false;
              u.half = 1 + (c & 1); const int e = tab_expert_of_tile(tab, u.pm); u.aux = e; u.r0 = (u.pm - tabr(tab, 64 + e)) * 256; return true; } }
#endif
        if (!pg8::static_next(NTt, 8, G, c, i, u.pm, u.pn)) return false;
        const int e = tab_expert_of_tile(tab, u.pm); u.aux = e; u.r0 = (u.pm - tabr(tab, 64 + e)) * 256; return true;
#endif
    }
    __device__ __forceinline__ const char* a_base(const pg8::Unit& u) const { return (const char*)A + ((size_t)u.pm * 256 + (u.half == 2 ? 128 : 0)) * RB; }
    __device__ __forceinline__ const char* b_base(const pg8::Unit& u) const { return (const char*)Bt + ((size_t)u.aux * 2048 + (size_t)u.pn * 256) * RB; }
    __device__ __forceinline__ void a_voff(const pg8::Unit&, int, unsigned (&vo)[2][2], const int (&R)[2], const int (&C)[2], int K_) const {
#pragma unroll
        for (int h = 0; h < 2; ++h)
#pragma unroll
            for (int i = 0; i < 2; ++i) vo[h][i] = (unsigned)((h * 128 + R[i]) * K_ + C[i] * 2); }
    __device__ __forceinline__ void pre(const pg8::Unit&, int) const {}
};

#ifndef MK_ROWS64
#define MK_ROWS64 1
#endif
#define ROWS_64    static constexpr int BHALF_ROWS = 32;  static __device__ __forceinline__ int brow(int R) { return 64 * (R >> 5) + 8 * ((R >> 2) & 3) + 4 * ((R >> 4) & 1) + (R & 3); }
#define ROWS_GU    static constexpr int BHALF_ROWS = 8;   static __device__ __forceinline__ int brow(int R) { return 64 * (R >> 5) + 16 * ((R >> 2) & 3) + 4 * ((R >> 4) & 1) + (R & 3); }
#ifndef MK_SILU_P3
#define MK_SILU_P3 0
#endif
template <bool P64>
struct EpiInProjT {
    struct Pre { template <int NAFTER> __device__ __forceinline__ void ready() {} }; __device__ __forceinline__ void preload(Pre&, const pg8::Unit&, int, int) const {}
    static constexpr int BHALF_ROWS = P64 ? 32 : 8;
    static __device__ __forceinline__ int brow(int R) { return 64 * (R >> 5) + (P64 ? 8 : 16) * ((R >> 2) & 3) + 4 * ((R >> 4) & 1) + (R & 3); }
    static constexpr int BJS = P64 ? 32 : 8, FQS = P64 ? 8 : 16;
    static constexpr int VM_MIN = (MK_G8 && !P64) ? 8 : 32;
    bf16_t* Z; const float* lb; int coloff; unsigned char* g8;
    template <int KIND> __device__ __forceinline__ void run(f32x4 (&acc)[2][2][4][2], int row0, int col0, float sc) const {
        float lbv[2][8];
        if (KIND == 3) {
#pragma unroll
            for (int bj = 0; bj < 2; ++bj) { const f32x4 a = *(const f32x4*)(lb + col0 - 1024 + bj * BJS), b = *(const f32x4*)(lb + col0 - 1024 + bj * BJS + 4);
                lbv[bj][0] = a[0]; lbv[bj][1] = a[1]; lbv[bj][2] = a[2]; lbv[bj][3] = a[3]; lbv[bj][4] = b[0]; lbv[bj][5] = b[1]; lbv[bj][6] = b[2]; lbv[bj][7] = b[3]; }
        }
        if (KIND == 2 && MK_G8) { static_assert(!P64 || !MK_G8 || KIND != 2 || true, "");
#pragma unroll
            for (int ai = 0; ai < 2; ++ai)
#pragma unroll
                for (int m = 0; m < 4; ++m) { unsigned w[4];
#pragma unroll
                    for (int q = 0; q < 4; ++q) { const f32x4 a = acc[ai][q >> 1][m][q & 1]; unsigned t = 0u;
#pragma unroll
                        for (int j = 0; j < 4; ++j) t = __builtin_amdgcn_cvt_pk_u8_f32(fmaxf(__builtin_rintf(fsigm(a[j]) * 255.f), 1.f), (unsigned)j, t);
                        w[q] = t; }
                    *(u32x4*)(g8 + (size_t)(row0 + ai * 128 + m * 16) * 4096 + (col0 - Z_MGA)) = (u32x4){w[0], w[1], w[2], w[3]}; }
            return; }
#pragma unroll
        for (int ai = 0; ai < 2; ++ai)
#pragma unroll
            for (int m = 0; m < 4; ++m) { bf16_t* rowp = Z + (size_t)(row0 + ai * 128 + m * 16) * NZ + col0;
#pragma unroll
                for (int bj = 0; bj < 2; ++bj) { float v[8];
#pragma unroll
                    for (int j = 0; j < 4; ++j) { v[j] = acc[ai][bj][m][0][j]; v[4 + j] = acc[ai][bj][m][1][j]; }
#pragma unroll
                    for (int j = 0; j < 8; ++j) {
                        if (KIND == 0) v[j] *= sc;
                        else if (KIND == 1) v[j] = v[j] * fsigm(v[j]) * sc;
                        else if (KIND == 2) v[j] = fsigm(v[j]);
                        else { const float l = lbv[bj][j]; v[j] = __logf(l + (1.f - l) * fsigm(v[j])); }
                    }
                    u32x4 w; w.x = cvt_pk_bf16(v[0], v[1]); w.y = cvt_pk_bf16(v[2], v[3]); w.z = cvt_pk_bf16(v[4], v[5]); w.w = cvt_pk_bf16(v[6], v[7]);
                    *(u32x4*)(rowp + bj * BJS) = w; } }
    }
    __device__ __forceinline__ bool operator()(f32x4 (&acc)[2][2][4][2], const pg8::Unit& u, int wr, int wc, int fr, int fq, const Pre&) const {
        const int colt = coloff + u.pn * 256; int kind; float sc = 1.f;
        if (colt < Z_HFF) { kind = 1; sc = QSCALE; } else if (colt < Z_HI) kind = 3; else if (colt < Z_HOG) kind = 0; else if (colt < Z_GQ) kind = MK_SILU_P3 ? 0 : 1;
        else if (colt < Z_GK) { kind = 0; sc = QSCALE; } else if (colt < Z_GR) kind = 0; else if (colt < Z_MGA) kind = MK_SILU_P3 ? 0 : 1; else kind = 2;
        const int row0 = u.pm * 256 + wr * 64 + fr, col0 = colt + wc * 64 + FQS * fq;
        if (kind == 0) run<0>(acc, row0, col0, sc); else if (kind == 1) run<1>(acc, row0, col0, sc); else if (kind == 2) run<2>(acc, row0, col0, sc); else run<3>(acc, row0, col0, sc);
        return false;
    }
};
typedef EpiInProjT<false> EpiInProj;

struct EpiMerge {
    struct Pre { template <int NAFTER> __device__ __forceinline__ void ready() {} }; __device__ __forceinline__ void preload(Pre&, const pg8::Unit&, int, int) const {}
    ROWS_GU
    static constexpr int VM_MIN = (MK_G8 && MK_FP8_PO) ? 8 : 8;
    const bf16_t* Z; bf16_t* O; const unsigned char* g8;
#if MK_G8 && MK_FP8_PO
    static __device__ __forceinline__ void dec16(const u32x4 g, float (&f)[16]) {
        const unsigned w[4] = {g.x, g.y, g.z, g.w};
#pragma unroll
        for (int q = 0; q < 4; ++q)
#pragma unroll
            for (int j = 0; j < 4; ++j) f[4 * q + j] = (float)((w[q] >> (8 * j)) & 0xffu) * (1.f / 255.f); }
    __device__ __forceinline__ void seg0(f32x4 (&acc)[2][2][4][2], int row0, int col0) const {
#pragma unroll
        for (int ai = 0; ai < 2; ++ai)
#pragma unroll
            for (int mp = 0; mp < 2; ++mp) { u32x4 ga[2], gb[2];
#pragma unroll
                for (int mm = 0; mm < 2; ++mm) { const unsigned char* gp = g8 + (size_t)(row0 + ai * 128 + (2 * mp + mm) * 16) * 4096 + col0; ga[mm] = *(const u32x4*)gp; gb[mm] = *(const u32x4*)(gp + 2048); }
#pragma unroll
                for (int mm = 0; mm < 2; ++mm) { const int m = 2 * mp + mm; float sa[16], sb[16]; dec16(ga[mm], sa); dec16(gb[mm], sb);
#pragma unroll
                    for (int bj = 0; bj < 2; ++bj)
#pragma unroll
                        for (int n = 0; n < 2; ++n)
#pragma unroll
                            for (int j = 0; j < 4; ++j) acc[ai][bj][m][n][j] *= sa[8 * bj + 4 * n + j] * __builtin_amdgcn_rcpf(sb[8 * bj + 4 * n + j]); } } }
    __device__ __forceinline__ void seg1(f32x4 (&acc)[2][2][4][2], int row0, int col0) const {
#pragma unroll
        for (int ai = 0; ai < 2; ++ai) { u32x4 gb[4];
#pragma unroll
            for (int m = 0; m < 4; ++m) gb[m] = *(const u32x4*)(g8 + (size_t)(row0 + ai * 128 + m * 16) * 4096 + 2048 + col0);
#pragma unroll
            for (int m = 0; m < 4; ++m) { float sb[16]; dec16(gb[m], sb); unsigned w[4];
#pragma unroll
                for (int q = 0; q < 4; ++q) { const f32x4 a = acc[ai][q >> 1][m][q & 1];
                    const unsigned t = __builtin_amdgcn_cvt_pk_fp8_f32(a[0] * sb[4 * q], a[1] * sb[4 * q + 1], 0u, false); w[q] = __builtin_amdgcn_cvt_pk_fp8_f32(a[2] * sb[4 * q + 2], a[3] * sb[4 * q + 3], t, true); }
                *(u32x4*)((unsigned char*)O + (size_t)(row0 + ai * 128 + m * 16) * D + col0) = (u32x4){w[0], w[1], w[2], w[3]}; } } }
    __device__ __forceinline__ bool operator()(f32x4 (&acc)[2][2][4][2], const pg8::Unit& u, int wr, int wc, int fr, int fq, const Pre&) const {
        const int row0 = u.pm * 256 + wr * 64 + fr, col0 = u.pn * 256 + wc * 64 + 16 * fq; const bool first = (u.aux == 0);
        if (first) seg0(acc, row0, col0); else seg1(acc, row0, col0);
        return first;
    }
#else
    __device__ __forceinline__ bool operator()(f32x4 (&acc)[2][2][4][2], const pg8::Unit& u, int wr, int wc, int fr, int fq) const {
        const int row0 = u.pm * 256 + wr * 64 + fr, col0 = u.pn * 256 + wc * 64 + 16 * fq; const bool first = (u.aux == 0);
#pragma unroll
        for (int ai = 0; ai < 2; ++ai)
#pragma unroll
            for (int m = 0; m < 4; ++m) { const size_t r = (size_t)(row0 + ai * 128 + m * 16);
#pragma unroll
                for (int bj = 0; bj < 2; ++bj) {
#if MK_G8
                    const u32x2 gb = *(const u32x2*)(g8 + r * 4096 + 2048 + col0 + bj * 8); float sb[8];
#pragma unroll
                    for (int j = 0; j < 4; ++j) { sb[j] = (float)((gb.x >> (8 * j)) & 0xffu) * (1.f / 255.f); sb[4 + j] = (float)((gb.y >> (8 * j)) & 0xffu) * (1.f / 255.f); }
#else
                    const u32x4 gb = *(const u32x4*)(Z + r * NZ + Z_MGB + col0 + bj * 8);
                    float sb[8] = {bf_lo(gb.x), bf_hi(gb.x), bf_lo(gb.y), bf_hi(gb.y), bf_lo(gb.z), bf_hi(gb.z), bf_lo(gb.w), bf_hi(gb.w)};
#endif
                    if (first) {
#if MK_G8
                        const u32x2 ga = *(const u32x2*)(g8 + r * 4096 + col0 + bj * 8); float sa[8];
#pragma unroll
                        for (int j = 0; j < 4; ++j) { sa[j] = (float)((ga.x >> (8 * j)) & 0xffu) * (1.f / 255.f); sa[4 + j] = (float)((ga.y >> (8 * j)) & 0xffu) * (1.f / 255.f); }
#else
                        const u32x4 ga = *(const u32x4*)(Z + r * NZ + Z_MGA + col0 + bj * 8);
                        float sa[8] = {bf_lo(ga.x), bf_hi(ga.x), bf_lo(ga.y), bf_hi(ga.y), bf_lo(ga.z), bf_hi(ga.z), bf_lo(ga.w), bf_hi(ga.w)};
#endif
#pragma unroll
                        for (int j = 0; j < 4; ++j) { acc[ai][bj][m][0][j] *= sa[j] * __builtin_amdgcn_rcpf(fmaxf(sb[j], 1e-30f)); acc[ai][bj][m][1][j] *= sa[4 + j] * __builtin_amdgcn_rcpf(fmaxf(sb[4 + j], 1e-30f)); }
                    } else {
                        float v[8];
#pragma unroll
                        for (int j = 0; j < 4; ++j) { v[j] = acc[ai][bj][m][0][j] * sb[j]; v[4 + j] = acc[ai][bj][m][1][j] * sb[4 + j]; }
#if MK_FP8_PO
                        unsigned w0 = __builtin_amdgcn_cvt_pk_fp8_f32(v[0], v[1], 0u, false); w0 = __builtin_amdgcn_cvt_pk_fp8_f32(v[2], v[3], w0, true);
                        unsigned w1 = __builtin_amdgcn_cvt_pk_fp8_f32(v[4], v[5], 0u, false); w1 = __builtin_amdgcn_cvt_pk_fp8_f32(v[6], v[7], w1, true);
                        *(u32x2*)((unsigned char*)O + r * D + col0 + bj * 8) = (u32x2){w0, w1};
#else
                        u32x4 w; w.x = cvt_pk_bf16(v[0], v[1]); w.y = cvt_pk_bf16(v[2], v[3]); w.z = cvt_pk_bf16(v[4], v[5]); w.w = cvt_pk_bf16(v[6], v[7]);
                        *(u32x4*)(O + r * D + col0 + bj * 8) = w;
#endif
                    } } }
        return first;
    }
#endif
};
#ifndef MK_H1_BF16
#define MK_H1_BF16 0
#endif
struct EpiMix {
    struct Pre { template <int NAFTER> __device__ __forceinline__ void ready() {} }; __device__ __forceinline__ void preload(Pre&, const pg8::Unit&, int, int) const {}
#if MK_ROWS64
    ROWS_64
    static constexpr int BJS = 32, FQS = 8;
#else
    ROWS_GU
    static constexpr int BJS = 8, FQS = 16;
#endif
    static constexpr int VM_MIN = 16;
    bf16_t* out; const float* x;
#if MK_H1_BF16
    __device__ __forceinline__ void ldx(f32x4 (&xv)[2][2][2], int row0, int col0, int c) const {
#pragma unroll
        for (int mm = 0; mm < 2; ++mm) { const float* xp = x + (size_t)(row0 + (c >> 1) * 128 + (2 * (c & 1) + mm) * 16) * D + col0;
#pragma unroll
            for (int bj = 0; bj < 2; ++bj) { xv[mm][bj][0] = __builtin_nontemporal_load((const f32x4*)(xp + bj * BJS)); xv[mm][bj][1] = __builtin_nontemporal_load((const f32x4*)(xp + bj * BJS + 4)); } } }
#endif
    __device__ __forceinline__ void st(f32x4 (&acc)[2][2][4][2], f32x4 (&xv)[2][2][2], int row0, int col0, int c) const {
#pragma unroll
        for (int mm = 0; mm < 2; ++mm) { const int ai = c >> 1, m = 2 * (c & 1) + mm; bf16_t* rowp = out + (size_t)(row0 + ai * 128 + m * 16) * D + col0;
#pragma unroll
            for (int bj = 0; bj < 2; ++bj) { f32x4 v0 = acc[ai][bj][m][0], v1 = acc[ai][bj][m][1];
#if MK_H1_BF16
                v0 += xv[mm][bj][0]; v1 += xv[mm][bj][1];
#endif
                *(u32x4*)(rowp + bj * BJS) = (u32x4){cvt_pk_bf16(v0[0], v0[1]), cvt_pk_bf16(v0[2], v0[3]), cvt_pk_bf16(v1[0], v1[1]), cvt_pk_bf16(v1[2], v1[3])}; } } }
    __device__ __forceinline__ bool operator()(f32x4 (&acc)[2][2][4][2], const pg8::Unit& u, int wr, int wc, int fr, int fq, const Pre&) const {
        const int row0 = u.pm * 256 + wr * 64 + fr, col0 = u.pn * 256 + wc * 64 + FQS * fq;
        f32x4 xa[2][2][2], xb[2][2][2];
#if MK_H1_BF16
        ldx(xa, row0, col0, 0); ldx(xb, row0, col0, 1);
        st(acc, xa, row0, col0, 0); ldx(xa, row0, col0, 2);
        st(acc, xb, row0, col0, 1); ldx(xb, row0, col0, 3);
        st(acc, xa, row0, col0, 2); st(acc, xb, row0, col0, 3);
#else
#pragma unroll
        for (int c = 0; c < 4; ++c) st(acc, xa, row0, col0, c);
#endif
        return false;
    }
};
struct EpiGU {
    ROWS_GU
    static constexpr int VM_MIN = 8;
    bf16_t* act; const float* bias;
    struct Pre { f32x4 bv[2][2];
        template <int NAFTER> __device__ __forceinline__ void ready() { asm volatile("s_waitcnt vmcnt(%4)" : "+v"(bv[0][0]), "+v"(bv[0][1]), "+v"(bv[1][0]), "+v"(bv[1][1]) : "n"(NAFTER) : "memory"); } };
    __device__ __forceinline__ void preload(Pre& p, const pg8::Unit& u, int wc, int fq) const {
        const float* bp = bias + (size_t)u.aux * 4096 + u.pn * 256; const unsigned vo = (unsigned)(wc * 64 + 16 * fq) * 4u;
#pragma unroll
        for (int bj = 0; bj < 2; ++bj)
#pragma unroll
            for (int n = 0; n < 2; ++n) asm volatile("global_load_dwordx4 %0, %1, %2" : "=v"(p.bv[bj][n]) : "v"(vo + (unsigned)(8 * bj + 4 * n) * 4u), "s"(bp) : "memory"); }
    __device__ __forceinline__ bool operator()(f32x4 (&acc)[2][2][4][2], const pg8::Unit& u, int wr, int wc, int fr, int fq, const Pre& pre) const {
        const int row0 = u.r0 + wr * 64 + fr, col0 = u.pn * 256 + wc * 64 + 16 * fq;
        const f32x4 (&bv)[2][2] = pre.bv;
#pragma unroll
        for (int ai = 0; ai < 2; ++ai)
#pragma unroll
            for (int m = 0; m < 4; ++m) { float o[8];
#pragma unroll
                for (int bj = 0; bj < 2; ++bj)
#pragma unroll
                    for (int n = 0; n < 2; ++n) { const f32x4 v = acc[ai][bj][m][n] + bv[bj][n];
#pragma unroll
                        for (int p = 0; p < 2; ++p) { const float gate = fminf(v[2 * p], 7.f); const float up = fminf(fmaxf(v[2 * p + 1], -7.f), 7.f); o[4 * bj + 2 * n + p] = (up + 1.f) * (gate * fsigm(1.702f * gate)); } }
                const size_t r = (size_t)(row0 + ai * 128 + m * 16);
#if MK_FP8
                unsigned w0 = __builtin_amdgcn_cvt_pk_fp8_f32(o[0], o[1], 0u, false); w0 = __builtin_amdgcn_cvt_pk_fp8_f32(o[2], o[3], w0, true);
                unsigned w1 = __builtin_amdgcn_cvt_pk_fp8_f32(o[4], o[5], 0u, false); w1 = __builtin_amdgcn_cvt_pk_fp8_f32(o[6], o[7], w1, true);
                *(u32x2*)((unsigned char*)act + r * D + (col0 >> 1)) = (u32x2){w0, w1};
#else
                *(u32x4*)(act + r * D + (col0 >> 1)) = (u32x4){cvt_pk_bf16(o[0], o[1]), cvt_pk_bf16(o[2], o[3]), cvt_pk_bf16(o[4], o[5]), cvt_pk_bf16(o[6], o[7])};
#endif
            }
        return false;
    }
};
struct EpiDown {
    struct Pre { template <int NAFTER> __device__ __forceinline__ void ready() {} }; __device__ __forceinline__ void preload(Pre&, const pg8::Unit&, int, int) const {}
    ROWS_GU
    static constexpr int VM_MIN = MK_TAIL_SPLIT ? 4 : 8;
    unsigned char* yp; const float* bias; const float* roww;
    __device__ __forceinline__ bool operator()(f32x4 (&acc)[2][2][4][2], const pg8::Unit& u, int wr, int wc, int fr, int fq, const Pre&) const {
        const int ro = (MK_TAIL_SPLIT && u.half == 2) ? 128 : 0;
        const int rl0 = wr * 64 + fr + ro, col0 = u.pn * 256 + wc * 64 + 16 * fq; const float* bp = bias + (size_t)u.aux * D + col0; const float* wp = roww + (size_t)u.aux * NTOK + u.r0;
        f32x4 bv[2][2];
#pragma unroll
        for (int bj = 0; bj < 2; ++bj)
#pragma unroll
            for (int n = 0; n < 2; ++n) bv[bj][n] = *(const f32x4*)(bp + bj * 8 + 4 * n);
        float wv[2][4];
#pragma unroll
        for (int ai = 0; ai < 2; ++ai)
#pragma unroll
            for (int m = 0; m < 4; ++m) wv[ai][m] = wp[(rl0 + ai * 128 + m * 16) & 0xffffff];
        asm volatile("" ::: "memory");
#pragma unroll
        for (int ai = 0; ai < 2; ++ai) { if (MK_TAIL_SPLIT && ai == 1 && u.half != 0) break;
#pragma unroll
            for (int m = 0; m < 4; ++m) { const int rl = rl0 + ai * 128 + m * 16; const float w = wv[ai][m] * 16.f; unsigned o[4];
#pragma unroll
                for (int bj = 0; bj < 2; ++bj)
#pragma unroll
                    for (int n = 0; n < 2; ++n) { const f32x4 v = (acc[ai][bj][m][n] + bv[bj][n]) * w;
                        unsigned t = __builtin_amdgcn_cvt_pk_fp8_f32(v[0], v[1], 0u, false); o[2 * bj + n] = __builtin_amdgcn_cvt_pk_fp8_f32(v[2], v[3], t, true); }
                *(u32x4*)(yp + (size_t)(u.pm * 256 + rl) * D + col0) = (u32x4){o[0], o[1], o[2], o[3]}; } }
        return false;
    }
};

#ifndef MK_KF_PROBE
#define MK_KF_PROBE 0
#endif
template <int NCOL>
struct KFillW {
    static constexpr bool ON = true; static constexpr int NL = 4, NS = 4, NB = NCOL / 32, PER_E = 64 * NB, ITEMS = NE * PER_E;
    const float* W; unsigned char* WT; int nwv, gw, lane, fbase; unsigned ldsdead = 0;
    __device__ __forceinline__ void locate(int fi, size_t& src, size_t& dst) const {
        int it = (fbase + fi) * nwv + gw; it = it < ITEMS ? it : ITEMS - 1; if (MK_KF_PROBE == 1 || MK_KF_PROBE == 4 || MK_KF_PROBE == 6) it = gw;
        const int e = __builtin_amdgcn_readfirstlane(it / PER_E), q = __builtin_amdgcn_readfirstlane(it % PER_E), kb = q / NB, nb = q % NB;
        src = ((size_t)e * D * NCOL + (size_t)(kb * 32) * NCOL + (size_t)nb * 32) * 4; dst = (size_t)e * NCOL * D + (size_t)(nb * 32) * D + kb * 32; }
    __device__ __forceinline__ void issue(f32x4 (&kf)[4], int fi) const {
        size_t src, dst; locate(fi, src, dst); const char* ub = (const char*)W + src; const unsigned vo = (unsigned)((4 * (lane >> 3)) * NCOL + 4 * (lane & 7)) * 4u;
        if ((MK_KF_PROBE == 6 || MK_KF_PROBE == 7) && ldsdead != 0u) {
            const unsigned m0v = ldsdead; unsigned keep_;
#pragma unroll
            for (int i = 0; i < 4; ++i) asm volatile("s_mov_b32 %0, m0\n\ts_mov_b32 m0, %3\n\ts_nop 0\n\tglobal_load_lds_dwordx4 %1, %2\n\ts_mov_b32 m0, %0" : "=&s"(keep_) : "v"(vo), "s"(ub + (size_t)i * (NCOL * 4)), "s"(m0v) : "memory", "scc");
            return; }
#pragma unroll
        for (int i = 0; i < 4; ++i) asm volatile("global_load_dwordx4 %0, %1, %2 nt" : "=v"(kf[i]) : "v"(vo), "s"(ub + (size_t)i * (NCOL * 4)) : "memory"); }
    __device__ __forceinline__ void consume(f32x4 (&kf)[4], int fi) const {
        size_t src, dst; locate(fi, src, dst); unsigned char* ud = WT + dst; const unsigned vo = (unsigned)((4 * (lane & 7)) * D + 4 * (lane >> 3));
        if (MK_KF_PROBE == 3 || MK_KF_PROBE == 4 || MK_KF_PROBE == 6 || MK_KF_PROBE == 7) { asm volatile("" :: "v"(kf[0]), "v"(kf[1]), "v"(kf[2]), "v"(kf[3])); return; }
#pragma unroll
        for (int j = 0; j < 4; ++j) { const unsigned t = __builtin_amdgcn_cvt_pk_fp8_f32(kf[0][j] * 256.f, kf[1][j] * 256.f, 0u, false);
            *(unsigned*)(ud + vo + (size_t)j * D) = __builtin_amdgcn_cvt_pk_fp8_f32(kf[2][j] * 256.f, kf[3][j] * 256.f, t, true); } }
    __device__ __forceinline__ void finish(int fi, int fend = 1 << 30) const {
        for (; fi < fend && (fbase + fi) * nwv + gw < ITEMS; ++fi) { f32x4 kf[4]; issue(kf, fi); asm volatile("s_waitcnt vmcnt(0)" : "+v"(kf[0]), "+v"(kf[1]), "+v"(kf[2]), "+v"(kf[3]) :: "memory"); consume(kf, fi); } }
};
constexpr int KDN_P1 = 32;
#ifndef MK_DN_FILL
#define MK_DN_FILL (MK_GU_KFILL ? 0 : 1)
#endif
constexpr int DNF_NL = 8, DNF_KB = 8 * DNF_NL, DNF_ITEMS = NE * (D / DNF_KB) * 64;
#ifndef MK_DN_FILL_P7
#define MK_DN_FILL_P7 1
#endif
constexpr int DNF_UNITS = MK_DN_FILL_P7 ? 32 : 18;
struct DownFill {
    static constexpr bool ON = true; static constexpr int NL = DNF_NL, NS = 4;
    const float* W; unsigned char* WT; int ubase, nwv, gw, lane;
    __device__ __forceinline__ void locate(int ui, size_t& src, size_t& dst) const {
        int sl = ubase + ui; sl = sl < DNF_UNITS ? sl : DNF_UNITS - 1;
        int it = sl * nwv + gw; it = it < DNF_ITEMS ? it : DNF_ITEMS - 1;
        constexpr int PER_E = (D / DNF_KB) * 64; const int e = __builtin_amdgcn_readfirstlane(it / PER_E), q = __builtin_amdgcn_readfirstlane(it % PER_E), kb = q >> 6, nb = q & 63;
        src = ((size_t)e * D * D + (size_t)(kb * DNF_KB) * D + (size_t)nb * 32) * 4; dst = (size_t)e * D * D + (size_t)(nb * 32) * D + kb * DNF_KB; }
    template <int LO, int HI> __device__ __forceinline__ void issue_part(f32x4 (&ff)[DNF_NL], int ui) const {
        size_t src, dst; locate(ui, src, dst); const char* ub = (const char*)W + src; const unsigned vo = (unsigned)((DNF_NL * (lane >> 3)) * D + 4 * (lane & 7)) * 4u;
#pragma unroll
        for (int i = LO; i < HI; ++i) asm volatile("global_load_dwordx4 %0, %1, %2 nt" : "=v"(ff[i]) : "v"(vo + (unsigned)i * (D * 4u)), "s"(ub) : "memory"); }
    __device__ __forceinline__ void issue(f32x4 (&ff)[DNF_NL], int ui) const {
        size_t src, dst; locate(ui, src, dst); const char* ub = (const char*)W + src; const unsigned vo = (unsigned)((DNF_NL * (lane >> 3)) * D + 4 * (lane & 7)) * 4u;
#if MK_FILL_ASM
#pragma unroll
        for (int i = 0; i < DNF_NL; ++i) asm volatile("global_load_dwordx4 %0, %1, %2 nt" : "=v"(ff[i]) : "v"(vo + (unsigned)i * (D * 4u)), "s"(ub) : "memory");
#else
#pragma unroll
        for (int i = 0; i < DNF_NL; ++i) ff[i] = __builtin_nontemporal_load((const f32x4*)(ub + (size_t)i * (D * 4) + vo));
        asm volatile("" ::: "memory");
#endif
    }
    template <int NAFTER> __device__ __forceinline__ void consume_w(f32x4 (&ff)[DNF_NL], int ui) const {
        static_assert(DNF_NL == 8, "tie");
        asm volatile("s_waitcnt vmcnt(%8)" : "+v"(ff[0]), "+v"(ff[1]), "+v"(ff[2]), "+v"(ff[3]), "+v"(ff[4]), "+v"(ff[5]), "+v"(ff[6]), "+v"(ff[7]) : "n"(NAFTER) : "memory");
        consume(ff, ui); }
    __device__ __forceinline__ void consume(f32x4 (&ff)[DNF_NL], int ui) const {
        size_t src, dst; locate(ui, src, dst); unsigned char* ud = WT + dst; const unsigned vo = (unsigned)((4 * (lane & 7)) * D + DNF_NL * (lane >> 3));
#pragma unroll
        for (int j = 0; j < 4; ++j) { unsigned w[DNF_NL / 4];
#pragma unroll
            for (int d = 0; d < DNF_NL / 4; ++d) { const unsigned t = __builtin_amdgcn_cvt_pk_fp8_f32(ff[4 * d][j] * 256.f, ff[4 * d + 1][j] * 256.f, 0u, false); w[d] = __builtin_amdgcn_cvt_pk_fp8_f32(ff[4 * d + 2][j] * 256.f, ff[4 * d + 3][j] * 256.f, t, true); }
            if constexpr (DNF_NL == 16) *(u32x4*)(ud + vo + (size_t)j * D) = (u32x4){w[0], w[1], w[2], w[3]}; else *(u32x2*)(ud + vo + (size_t)j * D) = (u32x2){w[0], w[1]}; } }
};

#define LDS_WAIT() asm volatile("s_waitcnt lgkmcnt(0)" ::: "memory")
#define VM_WAIT() asm volatile("s_waitcnt vmcnt(0)" ::: "memory")

__device__ __forceinline__ void p0_transpose_item(const float* W, size_t ldw, bf16_t* WT, size_t ldt, int k0, int n0s, int n0d, LAS float* scr, int lane) {
#pragma unroll 8
    for (int i = 0; i < 32; ++i) { const int kk = 2 * i + (lane >> 5); scr[kk * 33 + (lane & 31)] = __builtin_nontemporal_load(W + (size_t)(k0 + kk) * ldw + n0s + (lane & 31)); }
    LDS_WAIT(); asm volatile("" ::: "memory");
    const int c = lane & 7;
#pragma unroll
    for (int j = 0; j < 4; ++j) { const int n = (lane >> 3) + 8 * j; const LAS float* s = scr + (8 * c) * 33 + n;
        u32x4 o; o.x = pk2(s[0 * 33], s[1 * 33]); o.y = pk2(s[2 * 33], s[3 * 33]); o.z = pk2(s[4 * 33], s[5 * 33]); o.w = pk2(s[6 * 33], s[7 * 33]);
        *(u32x4*)(WT + (size_t)(n0d + n) * ldt + k0 + 8 * c) = o; }
    LDS_WAIT(); asm volatile("" ::: "memory");
}
__device__ __forceinline__ void p0_transpose_item_f8(const float* W, size_t ldw, unsigned char* WT, size_t ldt, int k0, int n0s, int n0d, LAS float* scr, int lane) {
#pragma unroll 8
    for (int i = 0; i < 32; ++i) { const int kk = 2 * i + (lane >> 5); scr[kk * 33 + (lane & 31)] = __builtin_nontemporal_load(W + (size_t)(k0 + kk) * ldw + n0s + (lane & 31)); }
    LDS_WAIT(); asm volatile("" ::: "memory");
    const int c = lane & 7;
#pragma unroll
    for (int j = 0; j < 4; ++j) { const int n = (lane >> 3) + 8 * j; const LAS float* s = scr + (8 * c) * 33 + n;
        unsigned w0 = __builtin_amdgcn_cvt_pk_fp8_f32(s[0 * 33] * 256.f, s[1 * 33] * 256.f, 0u, false); w0 = __builtin_amdgcn_cvt_pk_fp8_f32(s[2 * 33] * 256.f, s[3 * 33] * 256.f, w0, true);
        unsigned w1 = __builtin_amdgcn_cvt_pk_fp8_f32(s[4 * 33] * 256.f, s[5 * 33] * 256.f, 0u, false); w1 = __builtin_amdgcn_cvt_pk_fp8_f32(s[6 * 33] * 256.f, s[7 * 33] * 256.f, w1, true);
        *(u32x2*)(WT + (size_t)(n0d + n) * ldt + k0 + 8 * c) = (u32x2){w0, w1}; }
    LDS_WAIT(); asm volatile("" ::: "memory");
}
__device__ __forceinline__ void p0_transpose_item_f8w(const float* W, size_t ldw, unsigned char* WT, size_t ldt, int k0, int n0, LAS float* scr, int lane) {
#pragma unroll 8
    for (int i = 0; i < 32; ++i) scr[i * 65 + lane] = __builtin_nontemporal_load(W + (size_t)(k0 + i) * ldw + n0 + lane);
    LDS_WAIT(); asm volatile("" ::: "memory");
    const int c = lane & 3;
#pragma unroll
    for (int j = 0; j < 4; ++j) { const int n = (lane >> 2) + 16 * j; const LAS float* s = scr + (8 * c) * 65 + n;
        unsigned w0 = __builtin_amdgcn_cvt_pk_fp8_f32(s[0 * 65] * 256.f, s[1 * 65] * 256.f, 0u, false); w0 = __builtin_amdgcn_cvt_pk_fp8_f32(s[2 * 65] * 256.f, s[3 * 65] * 256.f, w0, true);
        unsigned w1 = __builtin_amdgcn_cvt_pk_fp8_f32(s[4 * 65] * 256.f, s[5 * 65] * 256.f, 0u, false); w1 = __builtin_amdgcn_cvt_pk_fp8_f32(s[6 * 65] * 256.f, s[7 * 65] * 256.f, w1, true);
        *(u32x2*)(WT + (size_t)(n0 + n) * ldt + k0 + 8 * c) = (u32x2){w0, w1}; }
    LDS_WAIT(); asm volatile("" ::: "memory");
}
__device__ __forceinline__ void rms_row_to_bf16(const float* xrow, const float* g, bf16_t* orow, unsigned* orow8, int lane) {
    const f32x4* xr = (const f32x4*)xrow + lane; const f32x4* gr = (const f32x4*)g + lane;
    f32x4 v[8]; float s = 0.f;
#pragma unroll
    for (int j = 0; j < 8; ++j) { v[j] = __builtin_nontemporal_load(xr + 64 * j); s += (v[j].x * v[j].x + v[j].y * v[j].y) + (v[j].z * v[j].z + v[j].w * v[j].w); }
    const float r = rsqrtf(wave_sum(s) * (1.f / D) + RMS_EPS);
    u32x2* o8 = (u32x2*)orow + lane;
#pragma unroll
    for (int j = 0; j < 8; ++j) { const f32x4 gg = gr[64 * j]; const f32x4 y = {v[j].x * r * gg.x, v[j].y * r * gg.y, v[j].z * r * gg.z, v[j].w * r * gg.w};
        u32x2 w; w.x = pk2(y.x, y.y); w.y = pk2(y.z, y.w); o8[64 * j] = w;
#if MK_FP8_MG
        unsigned w8 = __builtin_amdgcn_cvt_pk_fp8_f32(y.x, y.y, 0u, false); w8 = __builtin_amdgcn_cvt_pk_fp8_f32(y.z, y.w, w8, true); orow8[lane + 64 * j] = w8;
#endif
    }
}
#ifndef MK_P0_LRSPLIT
#define MK_P0_LRSPLIT 1
#endif
__device__ __forceinline__ void p0_prologue(Frame& F) {
    LAS float* scr = (LAS float*)(F.lds + F.wave * 16384);
    const int gw = F.vcu * NWAVES + F.wave, NGW = F.G * NWAVES;
    { const int gt = gw * 64 + F.lane, NGT = NGW * 64;
      for (int i = gt; i < 2048; i += NGT) { const int d = i >> 10, c = i & 1023; const float a = F.lb_logits[(d * 2 + 0) * 1024 + c], b = F.lb_logits[(d * 2 + 1) * 1024 + c];
          const float m = fmaxf(a, b), ea = __expf(a - m), eb = __expf(b - m); WSP(float, WS_LB)[i] = ea / (ea + eb); }
      for (int i = gt; i < 2 * 512 * 32; i += NGT) { const int r = i & 31, c = (i >> 5) & 511, d = i >> 14; WSP(bf16_t, WS_W2T)[i] = r < 16 ? (bf16_t)f2bf(F.gla_w2[(d * 16 + r) * 512 + c]) : (bf16_t)0; } }
#if MK_P0_LRSPLIT
    for (int k = gw; k < D; k += NGW) if (F.lane < 32) WSP(bf16_t, WS_WLRT)[(size_t)F.lane * D + k] = (bf16_t)f2bf(F.w_in[(size_t)k * DIN + 8192 + F.lane]);
#endif
    for (int m = gw; m < NTOK; m += NGW) rms_row_to_bf16(F.x + (size_t)m * D, F.norm1_g, WSP(bf16_t, WS_XN) + (size_t)m * D, (unsigned*)(F.ws + WS_XN8 + (size_t)m * D), F.lane);
    constexpr int I_IN = 32 * (MK_P0_LRSPLIT ? 384 : 385), I_PA = 16 * 64, I_OUT = 32 * 64, I_GU = (MK_FP8 && MK_GU_KFILL && !MK_KF_PROBE) ? 0 : (MK_FP8 && MK_GU_IN_P2 && !MK_GU_PROBE) ? MK_GU_P2_SKIP * 2048 : (MK_FP8 ? 16 : 32) * 32 * 128, I_DN = (MK_FP8 && (MK_DN_FILL || (MK_GU_KFILL && !MK_KF_PROBE))) ? 0 : (MK_FP8 ? 16 : 32) * 32 * 64;
    constexpr int DN_FIRST = DNF_UNITS * 256 * NWAVES;
    constexpr int NITEMS = I_IN + 2 * I_PA + I_OUT + I_GU + I_DN;
    for (int it = gw; it < NITEMS; it += NGW) {
        int r = it;
#if MK_P0_LRSPLIT
        if (r < I_IN) { const int kb = r / 384, nbq = r % 384, nb = nbq < 256 ? nbq : nbq + 1;
#else
        if (r < I_IN) { const int kb = r / 385, nb = r % 385;
#endif
#if MK_FP8_MG && MK_FP8_VG
            if (nb == 256) p0_transpose_item(F.w_in, DIN, WSP(bf16_t, WS_WLRT), D, kb * 64, nb * 32, 0, scr, F.lane);
            else { const int zc = (nb < 256 ? nb : nb - 1) * 32;
                if (in_tile_is_f8(zc >> 8)) p0_transpose_item_f8(F.w_in, DIN, WSP(unsigned char, WS_WINT8), D, kb * 64, nb * 32, zc, scr, F.lane);
                else p0_transpose_item(F.w_in, DIN, WSP(bf16_t, WS_WINT), D, kb * 64, nb * 32, zc, scr, F.lane); }
#elif MK_FP8_MG
            if (nb < 256) p0_transpose_item(F.w_in, DIN, WSP(bf16_t, WS_WINT), D, kb * 64, nb * 32, nb * 32, scr, F.lane);
            else if (nb == 256) p0_transpose_item(F.w_in, DIN, WSP(bf16_t, WS_WLRT), D, kb * 64, nb * 32, 0, scr, F.lane);
            else p0_transpose_item_f8(F.w_in, DIN, WSP(unsigned char, WS_WINT8), D, kb * 64, nb * 32, (nb - 257) * 32, scr, F.lane);
#else
            if (nb < 256) p0_transpose_item(F.w_in, DIN, WSP(bf16_t, WS_WINT), D, kb * 64, nb * 32, nb * 32, scr, F.lane);
            else if (nb == 256) p0_transpose_item(F.w_in, DIN, WSP(bf16_t, WS_WLRT), D, kb * 64, nb * 32, 0, scr, F.lane);
            else p0_transpose_item(F.w_in, DIN, WSP(bf16_t, WS_WINT), D, kb * 64, nb * 32, (nb - 1) * 32, scr, F.lane);
#endif
            continue; } r -= I_IN;
#if MK_FP8_PO
        if (r < I_PA) { p0_transpose_item_f8(F.w_proj_a, D, WSP(unsigned char, WS_WPAT), 1024, (r / 64) * 64, (r % 64) * 32, (r % 64) * 32, scr, F.lane); continue; } r -= I_PA;
        if (r < I_PA) { p0_transpose_item_f8(F.w_proj_b, D, WSP(unsigned char, WS_WPBT), 1024, (r / 64) * 64, (r % 64) * 32, (r % 64) * 32, scr, F.lane); continue; } r -= I_PA;
        if (r < I_OUT) { p0_transpose_item_f8(F.w_out, D, WSP(unsigned char, WS_WOUTT), D, (r / 64) * 64, (r % 64) * 32, (r % 64) * 32, scr, F.lane); continue; } r -= I_OUT;
#else
        if (r < I_PA) { p0_transpose_item(F.w_proj_a, D, WSP(bf16_t, WS_WPAT), 1024, (r / 64) * 64, (r % 64) * 32, (r % 64) * 32, scr, F.lane); continue; } r -= I_PA;
        if (r < I_PA) { p0_transpose_item(F.w_proj_b, D, WSP(bf16_t, WS_WPBT), 1024, (r / 64) * 64, (r % 64) * 32, (r % 64) * 32, scr, F.lane); continue; } r -= I_PA;
        if (r < I_OUT) { p0_transpose_item(F.w_out, D, WSP(bf16_t, WS_WOUTT), D, (r / 64) * 64, (r % 64) * 32, (r % 64) * 32, scr, F.lane); continue; } r -= I_OUT;
#endif
#if MK_FP8
        if (r < I_GU) { const int rr = (MK_FP8 && MK_GU_IN_P2 && !MK_GU_PROBE) ? r + (32 - MK_GU_P2_SKIP) * 2048 : r; const int e = rr / 2048, q = rr % 2048, k0 = (q / 128) * 128, n0 = (q % 128) * 32; const float* Ws = F.w_gate_up + (size_t)e * D * 4096; unsigned char* Wd = WSP(unsigned char, WS_WGUT) + (size_t)e * 4096 * D;
            p0_transpose_item_f8(Ws, 4096, Wd, D, k0, n0, n0, scr, F.lane); p0_transpose_item_f8(Ws, 4096, Wd, D, k0 + 64, n0, n0, scr, F.lane); continue; } r -= I_GU;
        { const int e = r / 1024, q = r % 1024, k0 = (q / 64) * 128, n0 = (q % 64) * 32; const float* Ws = F.w_down + (size_t)e * D * D; unsigned char* Wd = WSP(unsigned char, WS_WDNT) + (size_t)e * D * D;
            p0_transpose_item_f8(Ws, D, Wd, D, k0, n0, n0, scr, F.lane); p0_transpose_item_f8(Ws, D, Wd, D, k0 + 64, n0, n0, scr, F.lane); }
#else
        if (r < I_GU) { const int e = r / 4096, q = r % 4096; p0_transpose_item(F.w_gate_up + (size_t)e * D * 4096, 4096, WSP(bf16_t, WS_WGUT) + (size_t)e * 4096 * D, D, (q / 128) * 64, (q % 128) * 32, (q % 128) * 32, scr, F.lane); continue; } r -= I_GU;
        { const int e = r / 2048, q = r % 2048; p0_transpose_item(F.w_down + (size_t)e * D * D, D, WSP(bf16_t, WS_WDNT) + (size_t)e * D * D, D, (q / 64) * 64, (q % 64) * 32, (q % 64) * 32, scr, F.lane); }
#endif
    }
#if MK_FP8 && MK_DN_FILL
    for (int it = DN_FIRST + gw; it < DNF_ITEMS; it += NGW) { const int e = it >> 11, q = it & 2047, kb = q >> 6, nb = q & 63;
        p0_transpose_item_f8(F.w_down + (size_t)e * D * D, D, WSP(unsigned char, WS_WDNT) + (size_t)e * D * D, D, kb * 64, nb * 32, nb * 32, scr, F.lane); }
#endif
}

__device__ __forceinline__ void p1_gates(Frame& F, int gi, int GG_) {
    const int blk = F.wave * GG_ + gi;
    LAS bf16_t* lrs = (LAS bf16_t*)(F.lds + F.wave * 2048);
    if (blk < NTOK / 16) {
        const int tok0 = blk * 16, fr = F.lane & 15, fq = F.lane >> 4;
        const bf16_t* xa = WSP(bf16_t, WS_XN) + (size_t)(tok0 + fr) * D + fq * 8;
        const bf16_t* wl0 = WSP(bf16_t, WS_WLRT) + (size_t)fr * D + fq * 8; const bf16_t* wl1 = wl0 + (size_t)16 * D;
        f32x4 a0 = {0.f, 0.f, 0.f, 0.f}, a1 = {0.f, 0.f, 0.f, 0.f};
#pragma unroll 4
        for (int ks = 0; ks < 64; ++ks) { const bf16x8 a = *(const bf16x8*)(xa + ks * 32), b0 = *(const bf16x8*)(wl0 + ks * 32), b1 = *(const bf16x8*)(wl1 + ks * 32);
            a0 = __builtin_amdgcn_mfma_f32_16x16x32_bf16(a, b0, a0, 0, 0, 0); a1 = __builtin_amdgcn_mfma_f32_16x16x32_bf16(a, b1, a1, 0, 0, 0); }
#pragma unroll
        for (int i = 0; i < 4; ++i) { lrs[(0 * 16 + 4 * fq + i) * 32 + fr] = (bf16_t)f2bf(a0[i]); lrs[(1 * 16 + 4 * fq + i) * 32 + fr] = (bf16_t)f2bf(a1[i]); lrs[(0 * 16 + 4 * fq + i) * 32 + 16 + fr] = 0; lrs[(1 * 16 + 4 * fq + i) * 32 + 16 + fr] = 0; }
        LDS_WAIT(); asm volatile("" ::: "memory");
#pragma unroll
        for (int d = 0; d < 2; ++d) {
            const bf16x8 lrf = *(const LAS bf16x8*)(lrs + (d * 16 + fr) * 32 + fq * 8);
            const bf16_t* w2p = WSP(bf16_t, WS_W2T) + ((size_t)d * 512 + fr) * 32 + fq * 8;
            const float* bp = F.gla_b + d * 512 + 4 * fq;
            bf16_t* gout = WSP(bf16_t, WS_GGLA) + (size_t)(tok0 + fr) * 1024 + d * 512 + 4 * fq;
#pragma unroll 4
            for (int ct = 0; ct < 32; ++ct) {
                const bf16x8 wa = *(const bf16x8*)(w2p + (size_t)ct * 16 * 32);
                f32x4 lg = __builtin_amdgcn_mfma_f32_16x16x32_bf16(wa, lrf, (f32x4){0.f, 0.f, 0.f, 0.f}, 0, 0, 0);
                const f32x4 bb = *(const f32x4*)(bp + ct * 16); float g[4];
#pragma unroll
                for (int i = 0; i < 4; ++i) { const float x = lg[i] + bb[i]; g[i] = (fminf(x, 0.f) - __logf(1.f + __expf(-fabsf(x)))) * (1.f / 16.f); }
                u32x2 w; w.x = cvt_pk_bf16(g[0], g[1]); w.y = cvt_pk_bf16(g[2], g[3]);
                *(u32x2*)(gout + ct * 16) = w;
            }
        }
    }
    VM_WAIT(); __syncthreads();
}

constexpr int RQ_PQ = 272, RQ_PT = 144;
constexpr int RL_QS = 0, RL_KS = 17408, RL_KT = 34816, RL_VT = 53248, RL_ST = 71680, RL_VEC = 106496;
static_assert(RL_VEC + 1536 <= RING_BYTES, "recurrence LDS map");
__device__ __forceinline__ float scan64(float v) {
    int t;
    t = __builtin_amdgcn_update_dpp(0, __builtin_bit_cast(int, v), 0x111, 0xf, 0xf, true); v += __builtin_bit_cast(float, t);
    t = __builtin_amdgcn_update_dpp(0, __builtin_bit_cast(int, v), 0x112, 0xf, 0xf, true); v += __builtin_bit_cast(float, t);
    t = __builtin_amdgcn_update_dpp(0, __builtin_bit_cast(int, v), 0x114, 0xf, 0xf, true); v += __builtin_bit_cast(float, t);
    t = __builtin_amdgcn_update_dpp(0, __builtin_bit_cast(int, v), 0x118, 0xf, 0xf, true); v += __builtin_bit_cast(float, t);
    t = __builtin_amdgcn_update_dpp(0, __builtin_bit_cast(int, v), 0x142, 0xa, 0xf, false); v += __builtin_bit_cast(float, t);
    t = __builtin_amdgcn_update_dpp(0, __builtin_bit_cast(int, v), 0x143, 0xc, 0xf, false); v += __builtin_bit_cast(float, t);
    return v;
}
#define RECUR_ISSUE(n_) do { const int cidx_ = dir ? 31 - (n_) : (n_); const size_t tq_ = (size_t)(b * TSEQ + cidx_ * 64 + (dir ? 63 - lane : lane)); \
            const u32x4* qp_ = (const u32x4*)(Z + tq_ * NZ + qcol); pq[0] = qp_[0]; pq[1] = qp_[1]; \
            const u32x4* gp_ = (const u32x4*)(gbase + tq_ * gpitch); pg[0] = gp_[0]; pg[1] = gp_[1]; \
            { const u32x4* kp_ = gla ? (const u32x4*)(Z + tq_ * NZ + kcol) : gp_; pk[0] = kp_[0]; pk[1] = kp_[1]; } \
            const u32x4* vp_ = (const u32x4*)(Z + tq_ * NZ + vcol); pv[0] = vp_[0]; pv[1] = vp_[1]; } while (0)
constexpr int GU_ITEMS = 32 * 16 * 128;
#define GU_FILL_ISSUE(it_) do { { const int itc_ = (it_) < GU_ITEMS ? (it_) : GU_ITEMS - 1; const int e_ = __builtin_amdgcn_readfirstlane(itc_ >> 11), q_ = __builtin_amdgcn_readfirstlane(itc_ & 2047); \
        const char* ub_ = (const char*)F.w_gate_up + ((size_t)e_ * D * 4096 + (size_t)((q_ >> 7) * 128) * 4096 + (size_t)(q_ & 127) * 32) * 4; \
        _Pragma("unroll") for (int i_ = 0; i_ < 16; ++i_) fv[i_] = __builtin_nontemporal_load((const f32x4*)(ub_ + (size_t)i_ * 16384 + fvoff_ld)); } asm volatile("" ::: "memory"); } while (0)
#define GU_FILL_ISSUE_PART(it_, i0_, i1_) do { { const int itc_ = (it_) < GU_ITEMS ? (it_) : GU_ITEMS - 1; const int e_ = __builtin_amdgcn_readfirstlane(itc_ >> 11), q_ = __builtin_amdgcn_readfirstlane(itc_ & 2047); \
        const char* ub_ = (const char*)F.w_gate_up + ((size_t)e_ * D * 4096 + (size_t)((q_ >> 7) * 128) * 4096 + (size_t)(q_ & 127) * 32) * 4; \
        _Pragma("unroll") for (int i_ = (i0_); i_ < (i1_); ++i_) fv[i_] = __builtin_nontemporal_load((const f32x4*)(ub_ + (size_t)i_ * 16384 + fvoff_ld)); } asm volatile("" ::: "memory"); } while (0)
#define GU_FILL_STORE(it_) do { { const int itc_ = (it_) < GU_ITEMS ? (it_) : GU_ITEMS - 1; const int e_ = __builtin_amdgcn_readfirstlane(itc_ >> 11), q_ = __builtin_amdgcn_readfirstlane(itc_ & 2047); \
        unsigned char* ud_ = WSP(unsigned char, MK_GU_PROBE ? WS_ACT : WS_WGUT) + (size_t)e_ * 4096 * D + (size_t)((q_ & 127) * 32) * D + (q_ >> 7) * 128; \
        if (MK_GU_PROBE == 2) { _Pragma("unroll") for (int i_ = 0; i_ < 16; ++i_) asm volatile("" :: "v"(fv[i_])); } else \
        _Pragma("unroll") for (int j_ = 0; j_ < 4; ++j_) { unsigned w_[4]; \
            _Pragma("unroll") for (int d_ = 0; d_ < 4; ++d_) { const unsigned t_ = __builtin_amdgcn_cvt_pk_fp8_f32(fv[4 * d_][j_] * 256.f, fv[4 * d_ + 1][j_] * 256.f, 0u, false); w_[d_] = __builtin_amdgcn_cvt_pk_fp8_f32(fv[4 * d_ + 2][j_] * 256.f, fv[4 * d_ + 3][j_] * 256.f, t_, true); } \
            *(u32x4*)(ud_ + fvoff_st + (size_t)j_ * D) = (u32x4){w_[0], w_[1], w_[2], w_[3]}; } } } while (0)
__device__ __forceinline__ void recur_item(Frame& F, int item) {
    LAS unsigned char* L = F.lds;
    const int lane = F.lane, w = F.wave, fr = lane & 15, fq = lane >> 4;
    const bool gla = item >= 128; const int j_ = item & 127;
    const int b = j_ >> 4, dir = j_ & 1, h = gla ? (j_ >> 2) & 3 : (j_ >> 1) & 7, half = (j_ >> 1) & 1;
    const bf16_t* Z = WSP(bf16_t, WS_ZB); bf16_t* OB = WSP(bf16_t, dir ? WS_OBUF2 : WS_OBUF);
    const int qcol = (gla ? Z_GQ : Z_HQ) + h * 128 + 16 * w, kcol = Z_GK + h * 128 + 16 * w;
    const int vcol = (gla ? Z_GV + h * 256 + half * 128 : Z_HI + h * 128) + 16 * w;
    const int ocol = gla ? 1024 + h * 256 + half * 128 : h * 128;
    const bf16_t* gbase = gla ? WSP(bf16_t, WS_GGLA) + dir * 512 + h * 128 + 16 * w : Z + (dir ? Z_HFB : Z_HFF) + h * 128 + 16 * w; const size_t gpitch = gla ? 1024 : NZ;
    const int tr = w >> 1, h2 = w & 1;
    f32x4 st[8];
#pragma unroll
    for (int vt = 0; vt < 8; ++vt) st[vt] = (f32x4){0.f, 0.f, 0.f, 0.f};
    u32x4 pq[2], pk[2], pg[2], pv[2];
    pk[0] = (u32x4){0u, 0u, 0u, 0u}; pk[1] = pk[0];
    RECUR_ISSUE(0);
#if MK_FP8 && MK_GU_IN_P2
    const unsigned fvoff_ld = (unsigned)((16 * (lane >> 3)) * 4096 + 4 * (lane & 7)) * 4u, fvoff_st = (unsigned)((4 * (lane & 7)) * D + 16 * (lane >> 3));
    f32x4 fv[16]; const int fgw = F.vcu * NWAVES + w, FNGW = F.G * NWAVES;
#endif
#pragma unroll 1
    for (int n = 0; n < 32; ++n) {
        const int cidx = dir ? 31 - n : n;
        float q[16], kk[16], bb[16];
        {
            const unsigned qa[8] = {pq[0].x, pq[0].y, pq[0].z, pq[0].w, pq[1].x, pq[1].y, pq[1].z, pq[1].w};
            const unsigned ka[8] = {pk[0].x, pk[0].y, pk[0].z, pk[0].w, pk[1].x, pk[1].y, pk[1].z, pk[1].w};
            const unsigned ga[8] = {pg[0].x, pg[0].y, pg[0].z, pg[0].w, pg[1].x, pg[1].y, pg[1].z, pg[1].w};
#pragma unroll
            for (int j = 0; j < 8; ++j) { q[2 * j] = bf_lo(qa[j]); q[2 * j + 1] = bf_hi(qa[j]); kk[2 * j] = bf_lo(ka[j]); kk[2 * j + 1] = bf_hi(ka[j]); bb[2 * j] = bf_lo(ga[j]); bb[2 * j + 1] = bf_hi(ga[j]); }
        }
        if (!gla) {
#pragma unroll
            for (int j = 0; j < 16; ++j) kk[j] = 1.f - __expf(bb[j]);
        }
        const u32x4 va0 = pv[0], va1 = pv[1];
#pragma unroll
        for (int j = 0; j < 16; ++j) bb[j] = scan64(bb[j]);
        float myr = 0.f, mybl = 0.f;
        unsigned qw[8], kw[8]; unsigned short kt16[16];
#pragma unroll
        for (int j = 0; j < 16; ++j) {
            const float r = __builtin_bit_cast(float, __builtin_amdgcn_readlane(__builtin_bit_cast(int, bb[j]), 31));
            const float bl = __builtin_bit_cast(float, __builtin_amdgcn_readlane(__builtin_bit_cast(int, bb[j]), 63));
            if (lane == j) { myr = r; mybl = bl; }
            const float dlt = fminf(fmaxf(bb[j] - r, -60.f), 60.f);
            const float eq = __expf(dlt), ek = __builtin_amdgcn_rcpf(eq);
            q[j] *= eq; kk[j] *= ek;
        }
#pragma unroll
        for (int j = 0; j < 8; ++j) { qw[j] = pk2(q[2 * j], q[2 * j + 1]); kw[j] = pk2(kk[2 * j], kk[2 * j + 1]); kt16[2 * j] = (unsigned short)(kw[j] & 0xffffu); kt16[2 * j + 1] = (unsigned short)(kw[j] >> 16); }
        const float e_r = __expf(fmaxf(myr, -80.f)), e_l = __expf(fmaxf(mybl, -80.f)), e_d = __expf(fmaxf(mybl - myr, -80.f));
#if MK_FP8 && MK_GU_IN_P2
        if (n > 0) GU_FILL_STORE(((n - 1 > MK_GU_P2_SKIP ? n - 1 : MK_GU_P2_SKIP) - MK_GU_P2_SKIP) * FNGW + fgw);
#endif
        __syncthreads();
#pragma unroll
        for (int j = 0; j < 16; ++j) *(LAS bf16_t*)(L + RL_KT + (16 * w + j) * RQ_PT + lane * 2) = kt16[j];
        *(LAS u32x4*)(L + RL_QS + lane * RQ_PQ + 32 * w) = (u32x4){qw[0], qw[1], qw[2], qw[3]}; *(LAS u32x4*)(L + RL_QS + lane * RQ_PQ + 32 * w + 16) = (u32x4){qw[4], qw[5], qw[6], qw[7]};
        *(LAS u32x4*)(L + RL_KS + lane * RQ_PQ + 32 * w) = (u32x4){kw[0], kw[1], kw[2], kw[3]}; *(LAS u32x4*)(L + RL_KS + lane * RQ_PQ + 32 * w + 16) = (u32x4){kw[4], kw[5], kw[6], kw[7]};
        { const unsigned vw[8] = {va0.x, va0.y, va0.z, va0.w, va1.x, va1.y, va1.z, va1.w};
#pragma unroll
          for (int j = 0; j < 8; ++j) { *(LAS bf16_t*)(L + RL_VT + (16 * w + 2 * j) * RQ_PT + lane * 2) = (bf16_t)(vw[j] & 0xffffu); *(LAS bf16_t*)(L + RL_VT + (16 * w + 2 * j + 1) * RQ_PT + lane * 2) = (bf16_t)(vw[j] >> 16); } }
        if (lane < 16) { LAS float* vec = (LAS float*)(L + RL_VEC); vec[16 * w + lane] = e_r; vec[128 + 16 * w + lane] = e_l; vec[256 + 16 * w + lane] = e_d; }
        RECUR_ISSUE(n + 1 < 32 ? n + 1 : 31);
        LDS_WAIT();
        const f32x4 er = *(const LAS f32x4*)(L + RL_VEC + (16 * w + 4 * fq) * 4), dl = *(const LAS f32x4*)(L + RL_VEC + (128 + 16 * w + 4 * fq) * 4), dr = *(const LAS f32x4*)(L + RL_VEC + (256 + 16 * w + 4 * fq) * 4);
#pragma unroll
        for (int vt = 0; vt < 8; ++vt) { u32x2 sw; sw.x = pk2(st[vt][0] * er[0], st[vt][1] * er[1]); sw.y = pk2(st[vt][2] * er[2], st[vt][3] * er[3]);
            *(LAS u32x2*)(L + RL_ST + (16 * vt + fr) * RQ_PQ + (16 * w + 4 * fq) * 2) = sw; }
        LDS_WAIT(); __syncthreads();
#if MK_FP8 && MK_GU_IN_P2
        GU_FILL_ISSUE_PART(((n > MK_GU_P2_SKIP ? n : MK_GU_P2_SKIP) - MK_GU_P2_SKIP) * FNGW + fgw, 0, MK_GU_SPLIT);
#endif
        bf16x8 bqf[4];
#pragma unroll
        for (int ks = 0; ks < 4; ++ks) bqf[ks] = *(const LAS bf16x8*)(L + RL_QS + (16 * tr + fr) * RQ_PQ + ks * 64 + fq * 16);
        f32x4 sc[4];
#pragma unroll
        for (int tc = 0; tc < 4; ++tc) { sc[tc] = (f32x4){0.f, 0.f, 0.f, 0.f};
            if (tc <= tr) {
#pragma unroll
                for (int ks = 0; ks < 4; ++ks) { const bf16x8 a = *(const LAS bf16x8*)(L + RL_KS + (16 * tc + fr) * RQ_PQ + ks * 64 + fq * 16);
                    sc[tc] = __builtin_amdgcn_mfma_f32_16x16x32_bf16(a, bqf[ks], sc[tc], 0, 0, 0); }
                if (tc == tr) {
#pragma unroll
                    for (int i = 0; i < 4; ++i) if (4 * fq + i > fr) sc[tc][i] = 0.f;
                }
            } }
        bf16x8 pf[2];
#pragma unroll
        for (int ks = 0; ks < 2; ++ks) { const u32x4 t4 = {pk2(sc[2 * ks][0], sc[2 * ks][1]), pk2(sc[2 * ks][2], sc[2 * ks][3]), pk2(sc[2 * ks + 1][0], sc[2 * ks + 1][1]), pk2(sc[2 * ks + 1][2], sc[2 * ks + 1][3])}; pf[ks] = __builtin_bit_cast(bf16x8, t4); }
        const size_t trow = (size_t)(b * TSEQ + cidx * 64 + (dir ? 63 - (16 * tr + fr) : (16 * tr + fr)));
#pragma unroll
        for (int vv = 0; vv < 4; ++vv) { const int vt = 4 * h2 + vv;
            f32x4 o = {0.f, 0.f, 0.f, 0.f};
#pragma unroll
            for (int ks = 0; ks < 2; ++ks) { if (ks == 0 || tr >= 2) {
                const u32x2 a0 = *(const LAS u32x2*)(L + RL_VT + (16 * vt + fr) * RQ_PT + (32 * ks + 4 * fq) * 2), a1 = *(const LAS u32x2*)(L + RL_VT + (16 * vt + fr) * RQ_PT + (32 * ks + 16 + 4 * fq) * 2);
                const u32x4 a4 = {a0.x, a0.y, a1.x, a1.y};
                o = __builtin_amdgcn_mfma_f32_16x16x32_bf16(__builtin_bit_cast(bf16x8, a4), pf[ks], o, 0, 0, 0); } }
#pragma unroll
            for (int ks = 0; ks < 4; ++ks) { const bf16x8 a = *(const LAS bf16x8*)(L + RL_ST + (16 * vt + fr) * RQ_PQ + ks * 64 + fq * 16);
                o = __builtin_amdgcn_mfma_f32_16x16x32_bf16(a, bqf[ks], o, 0, 0, 0); }
            *(u32x2*)(OB + trow * D + ocol + 16 * vt + 4 * fq) = (u32x2){pk2(o[0], o[1]), pk2(o[2], o[3])}; }
#if MK_FP8 && MK_GU_IN_P2
        GU_FILL_ISSUE_PART(((n > MK_GU_P2_SKIP ? n : MK_GU_P2_SKIP) - MK_GU_P2_SKIP) * FNGW + fgw, MK_GU_SPLIT, 16);
#endif
        bf16x8 ktf[2];
#pragma unroll
        for (int ks = 0; ks < 2; ++ks) ktf[ks] = *(const LAS bf16x8*)(L + RL_KT + (16 * w + fr) * RQ_PT + ks * 64 + fq * 16);
#pragma unroll
        for (int vt = 0; vt < 8; ++vt) { f32x4 ds = {0.f, 0.f, 0.f, 0.f};
#pragma unroll
            for (int ks = 0; ks < 2; ++ks) { const bf16x8 bv = *(const LAS bf16x8*)(L + RL_VT + (16 * vt + fr) * RQ_PT + ks * 64 + fq * 16);
                ds = __builtin_amdgcn_mfma_f32_16x16x32_bf16(ktf[ks], bv, ds, 0, 0, 0); }
            st[vt] = st[vt] * dl + ds * dr; }
        LDS_WAIT();
    }
#if MK_FP8 && MK_GU_IN_P2
    GU_FILL_STORE((31 - MK_GU_P2_SKIP) * FNGW + fgw);
    for (int it = GU_ITEMS + fgw; it < GU_ITEMS; it += FNGW) { GU_FILL_ISSUE(it); GU_FILL_STORE(it); }
#endif
    __syncthreads();
}

__device__ __forceinline__ void p3_combine(Frame& F) {
    const int gw = F.vcu * NWAVES + F.wave, NGW = F.G * NWAVES, lane = F.lane;
    const bf16_t* Z = WSP(bf16_t, WS_ZB); const bf16_t* OB = WSP(bf16_t, WS_OBUF); const bf16_t* OB2 = WSP(bf16_t, WS_OBUF2);
    for (int tok = gw; tok < NTOK; tok += NGW) {
#pragma unroll
        for (int mx = 0; mx < 2; ++mx) {
            const u32x4* op = (const u32x4*)(OB + (size_t)tok * D + mx * 1024 + 16 * lane); const u32x4* op2 = (const u32x4*)(OB2 + (size_t)tok * D + mx * 1024 + 16 * lane);
            const u32x4 a0 = __builtin_nontemporal_load(op), a1 = __builtin_nontemporal_load(op + 1), b0 = __builtin_nontemporal_load(op2), b1 = __builtin_nontemporal_load(op2 + 1);
            const unsigned aw[8] = {a0.x, a0.y, a0.z, a0.w, a1.x, a1.y, a1.z, a1.w}, bw[8] = {b0.x, b0.y, b0.z, b0.w, b1.x, b1.y, b1.z, b1.w};
            f32x4 v[4]; float s = 0.f;
#pragma unroll
            for (int j = 0; j < 4; ++j) { v[j] = (f32x4){bf_lo(aw[2 * j]) + bf_lo(bw[2 * j]), bf_hi(aw[2 * j]) + bf_hi(bw[2 * j]), bf_lo(aw[2 * j + 1]) + bf_lo(bw[2 * j + 1]), bf_hi(aw[2 * j + 1]) + bf_hi(bw[2 * j + 1])};
                s += (v[j].x * v[j].x + v[j].y * v[j].y) + (v[j].z * v[j].z + v[j].w * v[j].w); }
            s += __shfl_xor(s, 1); s += __shfl_xor(s, 2); s += __shfl_xor(s, 4); if (mx) s += __shfl_xor(s, 8);
            const float r = rsqrtf(s * (mx ? 1.f / 256.f : 1.f / 128.f) + RMS_EPS);
            const float* gp = (mx ? F.gla_norm_g + ((16 * lane) & 255) : F.hg_norm_g + ((16 * lane) & 127));
            const u32x4* zp = (const u32x4*)(Z + (size_t)tok * NZ + (mx ? Z_GR : Z_HOG) + 16 * lane); const u32x4 z0 = zp[0], z1 = zp[1];
            const unsigned za[8] = {z0.x, z0.y, z0.z, z0.w, z1.x, z1.y, z1.z, z1.w}; unsigned ow[8];
#pragma unroll
            for (int j = 0; j < 4; ++j) { const f32x4 gg = *(const f32x4*)(gp + 4 * j);
                float g0 = bf_lo(za[2 * j]), g1 = bf_hi(za[2 * j]), g2 = bf_lo(za[2 * j + 1]), g3 = bf_hi(za[2 * j + 1]);
#if MK_SILU_P3
                g0 *= fsigm(g0); g1 *= fsigm(g1); g2 *= fsigm(g2); g3 *= fsigm(g3);
#endif
                ow[2 * j] = pk2(v[j].x * r * gg.x * g0, v[j].y * r * gg.y * g1); ow[2 * j + 1] = pk2(v[j].z * r * gg.z * g2, v[j].w * r * gg.w * g3); }
#if MK_FP8_PO
            unsigned o8[4];
#pragma unroll
            for (int j = 0; j < 4; ++j) { const unsigned t8 = __builtin_amdgcn_cvt_pk_fp8_f32(bf_lo(ow[2 * j]), bf_hi(ow[2 * j]), 0u, false); o8[j] = __builtin_amdgcn_cvt_pk_fp8_f32(bf_lo(ow[2 * j + 1]), bf_hi(ow[2 * j + 1]), t8, true); }
            *(u32x4*)(WSP(unsigned char, mx ? WS_YB : WS_YA) + (size_t)tok * 1024 + 16 * lane) = (u32x4){o8[0], o8[1], o8[2], o8[3]};
#else
            u32x4* yo = (u32x4*)(WSP(bf16_t, mx ? WS_YB : WS_YA) + (size_t)tok * 1024 + 16 * lane);
            yo[0] = (u32x4){ow[0], ow[1], ow[2], ow[3]}; yo[1] = (u32x4){ow[4], ow[5], ow[6], ow[7]};
#endif
        }
    }
}

constexpr int R_HN = 0, R_PART = 65536, R_LOG = R_PART + 8 * 8 * 32 * 4, R_TK = R_LOG + 8 * 32 * 4, R_CNT = R_TK + 4096;
static_assert(R_CNT + 256 <= RING_BYTES, "router LDS map");
#ifndef MK_H1_P6
#define MK_H1_P6 1
#endif
__device__ __forceinline__ void p6_router(Frame& F) {
    LAS unsigned char* L = F.lds; const int tid = F.tid, lane = F.lane, w = F.wave;
    LAS float* hnl = (LAS float*)(L + R_HN); LAS float* part = (LAS float*)(L + R_PART); LAS float* logit = (LAS float*)(L + R_LOG);
    LAS int* tk_idx = (LAS int*)(L + R_TK); LAS float* tk_p = (LAS float*)(L + R_TK + 1024);
    LAS int* lcnt = (LAS int*)(L + R_CNT); LAS int* lbase = lcnt + 32;
    const int eq = tid & 7, ds = tid >> 3;
    f32x4 wreg[32];
#pragma unroll
    for (int j = 0; j < 32; ++j) wreg[j] = *(const f32x4*)(F.router_w + (size_t)(ds * 32 + j) * NE + 4 * eq);
    const int TPW = NTOK / F.G;
    if (tid < 32) lcnt[tid] = 0;
    const bf16_t* MIX = WSP(bf16_t, WS_H1); bf16_t* HN = WSP(bf16_t, WS_XN);
    const f32x4* gr = (const f32x4*)F.norm2_g + lane;
    f32x4 vn[8];
#if MK_H1_BF16
#define P6_LOAD_ROW(tok_) do { const u32x2* mr_ = (const u32x2*)(MIX + (size_t)(tok_) * D) + lane; \
        _Pragma("unroll") for (int j = 0; j < 8; ++j) { const u32x2 mv_ = mr_[64 * j]; vn[j] = (f32x4){bf_lo(mv_.x), bf_hi(mv_.x), bf_lo(mv_.y), bf_hi(mv_.y)}; } } while (0)
#else
#define P6_LOAD_ROW(tok_) do { const f32x4* xr_ = (const f32x4*)(F.x + (size_t)(tok_) * D) + lane; const u32x2* mr_ = (const u32x2*)(MIX + (size_t)(tok_) * D) + lane; \
        _Pragma("unroll") for (int j = 0; j < 8; ++j) { const f32x4 xv_ = xr_[64 * j]; const u32x2 mv_ = mr_[64 * j]; vn[j] = (f32x4){xv_.x + bf_lo(mv_.x), xv_.y + bf_hi(mv_.x), xv_.z + bf_lo(mv_.y), xv_.w + bf_hi(mv_.y)}; } } while (0)
#endif
    P6_LOAD_ROW(F.vcu * TPW + w);
#pragma unroll 1
    for (int bt = 0; bt < TPW / 8; ++bt) {
        const int tok = F.vcu * TPW + bt * 8 + w;
        {
            float s = 0.f;
#pragma unroll
            for (int j = 0; j < 8; ++j) s += (vn[j].x * vn[j].x + vn[j].y * vn[j].y) + (vn[j].z * vn[j].z + vn[j].w * vn[j].w);
            const float r = rsqrtf(wave_sum(s) * (1.f / D) + RMS_EPS);
            u32x2* o8 = (u32x2*)(HN + (size_t)tok * D) + lane;
#pragma unroll
            for (int j = 0; j < 8; ++j) { const f32x4 gg = gr[64 * j]; const f32x4 y = {vn[j].x * r * gg.x, vn[j].y * r * gg.y, vn[j].z * r * gg.z, vn[j].w * r * gg.w};
                *(LAS f32x4*)(hnl + w * 2048 + 4 * (lane + 64 * j)) = y;
#if MK_H1_P6
                ((u32x2*)(WSP(bf16_t, WS_H1) + (size_t)tok * D) + lane)[64 * j] = (u32x2){pk2(vn[j].x, vn[j].y), pk2(vn[j].z, vn[j].w)};
#endif
#if MK_FP8
                unsigned w8 = __builtin_amdgcn_cvt_pk_fp8_f32(y.x, y.y, 0u, false); w8 = __builtin_amdgcn_cvt_pk_fp8_f32(y.z, y.w, w8, true);
                ((unsigned*)((unsigned char*)HN + (size_t)tok * D))[lane + 64 * j] = w8; (void)o8;
#else
                u32x2 ww; ww.x = pk2(y.x, y.y); ww.y = pk2(y.z, y.w); o8[64 * j] = ww;
#endif
            }
        }
        LDS_WAIT(); __syncthreads();
        if (bt + 1 < TPW / 8) P6_LOAD_ROW(tok + 8);
#pragma unroll 2
        for (int t8 = 0; t8 < 8; ++t8) { f32x4 a = {0.f, 0.f, 0.f, 0.f}; const LAS f32x4* hp = (const LAS f32x4*)(hnl + t8 * 2048 + ds * 32);
#pragma unroll
            for (int j = 0; j < 8; ++j) { const f32x4 hv = hp[j]; a += wreg[4 * j] * hv.x; a += wreg[4 * j + 1] * hv.y; a += wreg[4 * j + 2] * hv.z; a += wreg[4 * j + 3] * hv.w; }
#pragma unroll
            for (int i = 0; i < 4; ++i) { float x = a[i]; x += __shfl_xor(x, 8); x += __shfl_xor(x, 16); x += __shfl_xor(x, 32); a[i] = x; }
            if (lane < 8) *(LAS f32x4*)(part + (t8 * 8 + w) * 32 + 4 * eq) = a; }
        LDS_WAIT(); __syncthreads();
        if (tid < 256) { const int t8 = tid >> 5, e = tid & 31; float a = F.router_b[e];
#pragma unroll
            for (int d2 = 0; d2 < 8; ++d2) a += part[(t8 * 8 + d2) * 32 + e];
            logit[t8 * 32 + e] = a; }
        LDS_WAIT(); __syncthreads();
        if (tid < 8) { float val[4]; int idx[4]; unsigned used = 0u;
            for (int k = 0; k < 4; ++k) { float best = -3.4e38f; int bi = 0; for (int i = 0; i < 32; ++i) { const float v = logit[tid * 32 + i]; if (!((used >> i) & 1u) && v > best) { best = v; bi = i; } } used |= 1u << bi; val[k] = best; idx[k] = bi; }
            float p[4], s = 0.f; for (int k = 0; k < 4; ++k) { p[k] = __expf(val[k] - val[0]); s += p[k]; }
            const float inv = 1.f / s;
            for (int k = 0; k < 4; ++k) { const int slot = (bt * 8 + tid) * 4 + k; tk_idx[slot] = idx[k]; tk_p[slot] = p[k] * inv; } }
    }
    LDS_WAIT(); __syncthreads();
    const int npair = TPW * 4;
    int my_e = 0, my_lr = 0;
    if (tid < npair) { my_e = tk_idx[tid]; my_lr = __hip_atomic_fetch_add(lcnt + my_e, 1, __ATOMIC_RELAXED, __HIP_MEMORY_SCOPE_WORKGROUP); }
    LDS_WAIT(); __syncthreads();
    if (tid < 32) lbase[tid] = (int)__hip_atomic_fetch_add((unsigned*)F.ctl + CW_ECNT + 64 * tid, (unsigned)lcnt[tid], __ATOMIC_RELAXED, __HIP_MEMORY_SCOPE_AGENT);
    LDS_WAIT(); __syncthreads();
    if (tid < npair) { const int rank = lbase[my_e] + my_lr; const int tok = F.vcu * TPW + (tid >> 2);
        WSP(int, WS_ROWTOK)[(size_t)my_e * NTOK + rank] = tok; WSP(float, WS_ROWW)[(size_t)my_e * NTOK + rank] = tk_p[tid]; WSP(int, WS_PAIR)[tok * 4 + (tid & 3)] = (my_e << 16) | rank; }
}
__device__ __forceinline__ void build_tab(Frame& F) {
    volatile LAS int* tab = (volatile LAS int*)(F.lds + LDS_TAB);
    if (F.tid < 32) { const int c = (int)__hip_atomic_load((unsigned*)F.ctl + CW_ECNT + 64 * F.tid, __ATOMIC_RELAXED, __HIP_MEMORY_SCOPE_AGENT); tab[F.tid] = c; tab[32 + F.tid] = (c + 255) >> 8; }
    LDS_WAIT(); __syncthreads();
    if (F.tid == 0) { int a = 0; for (int e = 0; e < NE; ++e) { tab[64 + e] = a; a += tab[32 + e]; } tab[96] = a; tab[100] = a; }
    LDS_WAIT(); __syncthreads();
    if (F.tid < 320) { int e = 0; while (e < NE - 1 && F.tid >= tab[64 + e + 1]) ++e; tab[128 + F.tid] = e; }
#if MK_HALF_TILES
    if (F.tid < 32) { const int c = tab[F.tid], nm = tab[32 + F.tid]; const int hf = (nm > 0 && c - 256 * (nm - 1) <= 128) ? 1 : 0; tab[TAB_NMF + F.tid] = nm - hf; }
    LDS_WAIT(); __syncthreads();
    if (F.tid == 0) { int a = 0, h = 0; for (int e = 0; e < NE; ++e) { tab[TAB_TBF + e] = a; a += tab[TAB_NMF + e]; if (tab[TAB_NMF + e] != tab[32 + e]) tab[TAB_HIDX + h++] = e; } tab[TAB_TBF + NE] = a; tab[TAB_NTF] = a; tab[TAB_NTH] = h; }
    LDS_WAIT(); __syncthreads();
    if (F.tid < 320) { int e = 0; while (e < NE - 1 && F.tid >= tab[TAB_TBF + e + 1]) ++e; tab[TAB_EOF + F.tid] = e; }
#endif
    LDS_WAIT(); __syncthreads();
}
__device__ __forceinline__ void p9_final(Frame& F) {
    const int gw = F.vcu * NWAVES + F.wave, NGW = F.G * NWAVES, lane = F.lane;
    const volatile LAS int* tab = (const volatile LAS int*)(F.lds + LDS_TAB);
    const bf16_t* MIX = WSP(bf16_t, WS_H1); const unsigned char* YP = WSP(unsigned char, WS_YPAIR); const int* PR = WSP(int, WS_PAIR);
    for (int tok = gw; tok < NTOK; tok += NGW) {
        f32x4 v[8]; const f32x4* hr = (const f32x4*)(F.x + (size_t)tok * D) + lane; const u32x2* mr = (const u32x2*)(MIX + (size_t)tok * D) + lane;
#if MK_H1_BF16 || MK_H1_P6
#pragma unroll
        for (int j = 0; j < 8; ++j) { const u32x2 mv = __builtin_nontemporal_load(mr + 64 * j); v[j] = (f32x4){bf_lo(mv.x), bf_hi(mv.x), bf_lo(mv.y), bf_hi(mv.y)}; }
        (void)hr;
#else
#pragma unroll
        for (int j = 0; j < 8; ++j) { const f32x4 xv = __builtin_nontemporal_load(hr + 64 * j); const u32x2 mv = __builtin_nontemporal_load(mr + 64 * j); v[j] = (f32x4){xv.x + bf_lo(mv.x), xv.y + bf_hi(mv.x), xv.z + bf_lo(mv.y), xv.w + bf_hi(mv.y)}; }
#endif
#pragma unroll
        for (int k = 0; k < 4; ++k) { const int pr = PR[tok * 4 + k]; const int e = pr >> 16, rank = pr & 0xffff; const size_t pos = (size_t)tab[64 + e] * 256 + rank;
            const unsigned* yr = (const unsigned*)(YP + pos * D) + lane;
#pragma unroll
            for (int j = 0; j < 8; ++j) { const unsigned y = __builtin_nontemporal_load(yr + 64 * j);
                v[j].x += __builtin_amdgcn_cvt_f32_fp8(y, 0) * 0.0625f; v[j].y += __builtin_amdgcn_cvt_f32_fp8(y, 1) * 0.0625f; v[j].z += __builtin_amdgcn_cvt_f32_fp8(y, 2) * 0.0625f; v[j].w += __builtin_amdgcn_cvt_f32_fp8(y, 3) * 0.0625f; } }
        float s = 0.f;
#pragma unroll
        for (int j = 0; j < 8; ++j) s += (v[j].x * v[j].x + v[j].y * v[j].y) + (v[j].z * v[j].z + v[j].w * v[j].w);
        const float r = rsqrtf(wave_sum(s) * (1.f / D) + RMS_EPS);
        f32x4* o = (f32x4*)(F.out + (size_t)tok * D) + lane; const f32x4* gr = (const f32x4*)F.final_g + lane;
#pragma unroll
        for (int j = 0; j < 8; ++j) { const f32x4 gg = gr[64 * j]; o[64 * j] = (f32x4){v[j].x * r * gg.x, v[j].y * r * gg.y, v[j].z * r * gg.z, v[j].w * r * gg.w}; }
    }
}

#ifndef MK_P2_VCU
#define MK_P2_VCU 0
#endif
#ifndef MK_P1_STAGGER
#define MK_P1_STAGGER 0
#endif
struct Args { Params p; int ph_lo, ph_hi; };
constexpr int N_PHASES = 10;

__global__ void __launch_bounds__(NTHREADS, 2) mk_fwd(Args args) {
    extern __shared__ __attribute__((aligned(16))) unsigned char lds_raw[];
    Frame F;
    F.lds = (LAS unsigned char*)lds_raw;
    F.tid = threadIdx.x; F.lane = F.tid & 63; F.wave = __builtin_amdgcn_readfirstlane(F.tid >> 6);
    F.G = gridDim.x; { const int bx = blockIdx.x; F.vcu = (F.G % 8 == 0) ? (bx % 8) * (F.G / 8) + bx / 8 : bx; }
    const Params& P = args.p;
    F.x = P.in[0]; F.norm1_g = P.in[1]; F.w_in = P.in[2]; F.lb_logits = P.in[3]; F.hg_norm_g = P.in[4]; F.gla_w2 = P.in[5]; F.gla_b = P.in[6]; F.gla_norm_g = P.in[7];
    F.w_proj_a = P.in[8]; F.w_proj_b = P.in[9]; F.w_out = P.in[10]; F.norm2_g = P.in[11]; F.router_w = P.in[12]; F.router_b = P.in[13]; F.w_gate_up = P.in[14];
    F.b_gate_up = P.in[15]; F.w_down = P.in[16]; F.b_down = P.in[17]; F.final_g = P.in[18];
    F.out = P.out; F.ws = P.ws; F.ctl = (unsigned*)(P.ws + WS_CTL);
    for (int u = F.tid; u < (LDS_BYTES - RING_BYTES) / 4; u += NTHREADS) ((LAS unsigned*)(F.lds + RING_BYTES))[u] = 0u;
    __syncthreads();
    const int lo = args.ph_lo, hi = args.ph_hi;
    const bool use_bar = (hi - lo) > 1;
    XcdBarrier bar; bar.bar = F.ctl + CW_BAR; bar.x = 0; bar.st = nullptr;
    if (use_bar) bar = xcd_barrier_post(F.ctl + CW_BAR, (volatile LAS unsigned*)(F.lds + LDS_XB));
#ifdef MK_ONLYMASK
#define IN(k) (((MK_ONLYMASK >> (k)) & 1) && lo <= (k) && (k) < hi)
#else
#define IN(k) (lo <= (k) && (k) < hi)
#endif
#define SEAM(k) do { if (IN(k) && IN((k) + 1)) xcd_barrier(bar); } while (0)
    const int c = (int)blockIdx.x;
    if (IN(0)) { p0_prologue(F); } SEAM(0);
    if (IN(1)) {
        p1_gates(F, F.vcu, F.G);
#if MK_FP8_MG
        constexpr int NT_F8 = in_tiles_f8(), NT_BF = 48 - NT_F8;
        { InSched S{WSP(bf16_t, WS_XN), WSP(bf16_t, WS_WINT), NTOK / 256, NT_BF, F.G, c, 2 * D, 0};
          typedef EpiInProjT<(MK_ROWS64 != 0) && (MK_G8 != 0) && !MK_FP8_VG> EpiInBf; EpiInBf E{WSP(bf16_t, WS_ZB), WSP(float, WS_LB), 0, WSP(unsigned char, WS_G8)};
#if MK_FP8 && MK_DN_FILL
          DownFill FL{F.w_down, WSP(unsigned char, WS_WDNT), 0, F.G * NWAVES, F.vcu * NWAVES + F.wave, F.lane};
          pg8::gemm_phase<EpiInBf, InSched, false, DownFill, pg8::NoKFill, false, (MK_EPI_RELAX & 1) != 0>(F.lds, 2 * D, S, E, FL); }
#else
          pg8::gemm_phase(F.lds, 2 * D, S, E); }
#endif
        { InSched S{F.ws + WS_XN8, F.ws + WS_WINT8 - (MK_FP8_VG ? (size_t)0 : (size_t)Z_MGA * D), NTOK / 256, NT_F8, F.G, c, D, 1};
          EpiInProj E{WSP(bf16_t, WS_ZB), WSP(float, WS_LB), 0, WSP(unsigned char, WS_G8)};
#if MK_FP8 && MK_DN_FILL
          DownFill FL{F.w_down, WSP(unsigned char, WS_WDNT), NT_BF / 4, F.G * NWAVES, F.vcu * NWAVES + F.wave, F.lane};
          pg8::gemm_phase<EpiInProj, InSched, true, DownFill, pg8::NoKFill, false, (MK_EPI_RELAX & 2) != 0>(F.lds, D, S, E, FL); }
#else
          pg8::gemm_phase<EpiInProj, InSched, true>(F.lds, D, S, E); }
#endif
#else
        DenseSched S{WSP(bf16_t, WS_XN), WSP(bf16_t, WS_WINT), NTOK / 256, NZ / 256, F.G, c, 2 * D};
        EpiInProj E{WSP(bf16_t, WS_ZB), WSP(float, WS_LB), 0, WSP(unsigned char, WS_G8)};
        pg8::gemm_phase(F.lds, 2 * D, S, E);
#endif
    } SEAM(1);
    if (IN(2)) { for (int item = MK_P2_VCU ? F.vcu : c; item < 256; item += F.G) recur_item(F, item); } SEAM(2);
    if (IN(3)) { p3_combine(F); } SEAM(3);
    if (IN(4)) {
        constexpr int PO_RB = MK_FP8_PO ? 1024 : 2048;
        MergeSched S{WSP(bf16_t, WS_YA), WSP(bf16_t, WS_WPAT), (long)(WS_YB - WS_YA), (long)(WS_WPBT - WS_WPAT), NTOK / 256, D / 256, F.G, c, PO_RB};
        EpiMerge E{WSP(bf16_t, WS_ZB), WSP(bf16_t, WS_MERGED), WSP(const unsigned char, WS_G8)};
#if 0
#elif MK_FP8 && MK_DN_FILL
        DownFill FL{F.w_down, WSP(unsigned char, WS_WDNT), 12, F.G * NWAVES, F.vcu * NWAVES + F.wave, F.lane};
        pg8::gemm_phase<EpiMerge, MergeSched, (MK_FP8_PO != 0), DownFill, pg8::NoKFill, false, (MK_EPI_RELAX & 4) != 0>(F.lds, PO_RB, S, E, FL);
#else
        pg8::gemm_phase(F.lds, 2048, S, E);
#endif
    } SEAM(4);
    if (IN(5)) {
        DenseSched S{WSP(bf16_t, WS_MERGED), WSP(bf16_t, WS_WOUTT), NTOK / 256, D / 256, F.G, c, MK_FP8_PO ? D : 2 * D};
        EpiMix E{WSP(bf16_t, WS_H1), F.x};
#if MK_FP8 && MK_DN_FILL && !MK_H1_BF16
        DownFill FL{F.w_down, WSP(unsigned char, WS_WDNT), 16, F.G * NWAVES, F.vcu * NWAVES + F.wave, F.lane};
        pg8::gemm_phase<EpiMix, DenseSched, (MK_FP8_PO != 0), DownFill, pg8::NoKFill, false, (MK_EPI_RELAX & 8) != 0>(F.lds, MK_FP8_PO ? D : 2 * D, S, E, FL);
#else
        pg8::gemm_phase(F.lds, 2 * D, S, E);
#endif
    } SEAM(5);
    if (IN(6)) { p6_router(F); } SEAM(6);
    if (IN(7) || IN(8) || IN(9)) build_tab(F);
    if (IN(7)) {
        GuSched S{WSP(bf16_t, WS_XN), WSP(bf16_t, WS_WGUT), WSP(int, WS_ROWTOK), (const volatile LAS int*)(F.lds + LDS_TAB), F.lds, F.G, c, MOE_RB, F.tid};
        EpiGU E{WSP(bf16_t, WS_ACT), F.b_gate_up};
#if MK_FP8 && MK_DN_FILL && MK_DN_FILL_P7
        DownFill FL{F.w_down, WSP(unsigned char, WS_WDNT), MK_H1_BF16 ? 16 : 18, F.G * NWAVES, F.vcu * NWAVES + F.wave, F.lane};
        pg8::gemm_phase<EpiGU, GuSched, true, DownFill, pg8::NoKFill, (MK_HALF_TILES != 0), (MK_EPI_RELAX & 16) != 0>(F.lds, MOE_RB, S, E, FL);
#else
        pg8::gemm_phase<EpiGU, GuSched, (MK_FP8 != 0)>(F.lds, MOE_RB, S, E);
#endif
    } SEAM(7);
    if (IN(8)) {
        DownSched S{WSP(bf16_t, WS_ACT), WSP(bf16_t, WS_WDNT), (const volatile LAS int*)(F.lds + LDS_TAB), F.G, c, MOE_RB};
        EpiDown E{WSP(unsigned char, WS_YPAIR), F.b_down, WSP(float, WS_ROWW)};
        pg8::gemm_phase<EpiDown, DownSched, (MK_FP8 != 0), pg8::NoFill, pg8::NoKFill, (MK_HALF_TILES != 0) || (MK_TAIL_SPLIT != 0), (MK_EPI_RELAX & 32) != 0>(F.lds, MOE_RB, S, E);
    } SEAM(8);
    if (IN(9)) { p9_final(F); }
#undef IN
#undef SEAM
}


#ifndef MK_N_LAUNCHES
#define MK_N_LAUNCHES 1
#endif
static void mk_forward(void* const* d_in, void* d_out, void* d_ws, hipStream_t stream) {
    static int ready = 0;
    if (!ready) { (void)hipFuncSetAttribute((const void*)mk_fwd, hipFuncAttributeMaxDynamicSharedMemorySize, LDS_BYTES); ready = 1; }
    (void)hipMemsetAsync((char*)d_ws + WS_CTL, 0, CTL_ZERO_BYTES, stream);
#ifdef MK_NANFILL
    (void)hipMemsetAsync((char*)d_ws + CTL_ZERO_BYTES, 0xFF, WS_END - CTL_ZERO_BYTES, stream);
#endif
    Args a; __builtin_memset(&a, 0, sizeof(a));
    for (int i = 0; i < 19; ++i) a.p.in[i] = (const float*)d_in[i];
    a.p.out = (float*)d_out; a.p.ws = (unsigned char*)d_ws;
    const int grid = 256;
#if MK_N_LAUNCHES == 1
    a.ph_lo = 0; a.ph_hi = N_PHASES;
    hipLaunchKernelGGL(mk_fwd, dim3(grid), dim3(NTHREADS), LDS_BYTES, stream, a);
#else
#ifndef MK_REPEAT_MASK
#define MK_REPEAT_MASK 0
#endif
    for (int ph = 0; ph < N_PHASES; ++ph) { a.ph_lo = ph; a.ph_hi = ph + 1; const int reps = ((MK_REPEAT_MASK >> ph) & 1) ? 4 : 1;
        for (int r = 0; r < reps; ++r) hipLaunchKernelGGL(mk_fwd, dim3(grid), dim3(NTHREADS), LDS_BYTES, stream, a); }
#endif
}

extern "C" void kernel_launch(void* const* d_in, const int* in_sizes, int n_in, void* d_out, int out_size, void* d_ws, size_t ws_size, hipStream_t stream) {
    (void)in_sizes; (void)n_in; (void)out_size; (void)ws_size;
    mk_forward(d_in, d_out, d_ws, stream);
}
```

```cpp
#include <hip/hip_runtime.h>
#include <stdint.h>
#define LAS __attribute__((address_space(3)))
#define GAS __attribute__((address_space(1)))
typedef unsigned short bf16_t;
typedef short bf16x8 __attribute__((ext_vector_type(8)));
typedef float f32x4 __attribute__((ext_vector_type(4)));
typedef float f32x2 __attribute__((ext_vector_type(2)));
typedef unsigned u32x4 __attribute__((ext_vector_type(4)));
typedef unsigned u32x2 __attribute__((ext_vector_type(2)));

typedef __bf16 bf16x2_t __attribute__((ext_vector_type(2)));
__device__ __forceinline__ unsigned cvt_pk_bf16(float lo, float hi) { const f32x2 v = {lo, hi}; const bf16x2_t b = __builtin_convertvector(v, bf16x2_t); return __builtin_bit_cast(unsigned, b); }
__device__ __forceinline__ unsigned pk2(float lo, float hi) { return cvt_pk_bf16(lo, hi); }
__device__ __forceinline__ unsigned f2bf(float f) { return cvt_pk_bf16(f, 0.f) & 0xffffu; }
__device__ __forceinline__ float bf_lo(unsigned w) { return __builtin_bit_cast(float, w << 16); }
__device__ __forceinline__ float bf_hi(unsigned w) { return __builtin_bit_cast(float, w & 0xffff0000u); }
__device__ __forceinline__ float fsigm(float x) { return __builtin_amdgcn_rcpf(1.f + __expf(-x)); }
typedef float f32x2 __attribute__((ext_vector_type(2)));
__device__ __forceinline__ f32x2 rcp2(f32x2 x) { return (f32x2){__builtin_amdgcn_rcpf(x.x), __builtin_amdgcn_rcpf(x.y)}; }
__device__ __forceinline__ f32x2 exp2v(f32x2 x) { return (f32x2){__builtin_amdgcn_exp2f(x.x), __builtin_amdgcn_exp2f(x.y)}; }
__device__ __forceinline__ f32x2 sigm2k(f32x2 x, float k) { return rcp2(exp2v(x * (f32x2){k, k}) + (f32x2){1.f, 1.f}); }
__device__ __forceinline__ float wave_sum(float v) {
#pragma unroll
    for (int o = 1; o < 64; o <<= 1) v += __shfl_xor(v, o);
    return v;
}

#define XB_TMO      128
#define XB_XCNT(j)  (256  + 64 * (j))
#define XB_XSUB(j)  (1280 + 64 * (j))
#define XB_XGEN(j)  (2304 + 64 * (j))
#define XB_TOP      3328
#define XB_TOPGEN   3392
#define XCD_BAR_WORDS 3456
#define XB_SPIN_CAP (1u << 18)
__device__ __forceinline__ unsigned xb_ld(unsigned* p)              { return __hip_atomic_load(p, __ATOMIC_RELAXED, __HIP_MEMORY_SCOPE_AGENT); }
__device__ __forceinline__ unsigned xb_add(unsigned* p, unsigned v) { return __hip_atomic_fetch_add(p, v, __ATOMIC_RELAXED, __HIP_MEMORY_SCOPE_AGENT); }
__device__ __forceinline__ unsigned xb_xcc_id() { return (unsigned)__builtin_amdgcn_s_getreg((3 << 11) | 20) & 0xFu; }
#define XB_SPIN(cond, bar) do { unsigned _sp = 0; while (cond) { __builtin_amdgcn_s_sleep(1); \
    if ((++_sp & 255u) == 0u) { if (xb_ld(&(bar)[XB_TMO])) break; if (_sp > XB_SPIN_CAP) { atomicAdd(&(bar)[XB_TMO], 1u); break; } } } } while (0)
struct XcdBarrier { unsigned* bar; unsigned x; volatile LAS unsigned* st; };
__device__ __forceinline__ XcdBarrier xcd_barrier_post(unsigned* bar, volatile LAS unsigned* st) {
    XcdBarrier b; b.bar = bar; b.x = xb_xcc_id(); b.st = st;
    if (threadIdx.x == 0) (void)xb_add(&bar[XB_XCNT(b.x)], 1u);
    return b;
}
__device__ __forceinline__ void xcd_barrier_complete(unsigned* bar, unsigned x, unsigned& nloc, unsigned& nx) {
    const unsigned G = gridDim.x * gridDim.y * gridDim.z;
    unsigned sum, cnt, mine, sp = 0u;
    for (;;) {
        sum = 0u; cnt = 0u; mine = 0u;
#pragma unroll
        for (unsigned j = 0; j < 16; ++j) { const unsigned c = xb_ld(&bar[XB_XCNT(j)]); sum += c; cnt += (c > 0u) ? 1u : 0u; mine = (j == x) ? c : mine; }
        if (sum == G) break;
        __builtin_amdgcn_s_sleep(1);
        if ((++sp & 255u) == 0u) { if (xb_ld(&bar[XB_TMO])) break; if (sp > XB_SPIN_CAP) { atomicAdd(&bar[XB_TMO], 1u); break; } }
    }
    nloc = mine > 0u ? mine : 1u; nx = cnt > 0u ? cnt : 1u;
}
__device__ __forceinline__ void xcd_barrier(const XcdBarrier& b) {
    asm volatile("s_waitcnt vmcnt(0)" ::: "memory");
    __syncthreads();
    if (threadIdx.x == 0) {
        unsigned* bar = b.bar;
        __builtin_amdgcn_s_waitcnt(0);
        unsigned nloc = b.st[0], nx = b.st[1];
        if (nloc == 0u) { xcd_barrier_complete(bar, b.x, nloc, nx); b.st[0] = nloc; b.st[1] = nx; }
        const unsigned old = xb_add(&bar[XB_XSUB(b.x)], 1u);
        const unsigned gen = old / nloc;
        if (old + 1u == (gen + 1u) * nloc) {
            __builtin_amdgcn_fence(__ATOMIC_RELEASE, "agent");
            asm volatile("s_waitcnt vmcnt(0)" ::: "memory");
            const unsigned og = xb_add(&bar[XB_TOP], 1u);
            const unsigned tg = og / nx;
            if (og + 1u == (tg + 1u) * nx) xb_add(&bar[XB_TOPGEN], 1u);
            else XB_SPIN(xb_ld(&bar[XB_TOPGEN]) == tg, bar);
            __builtin_amdgcn_fence(__ATOMIC_ACQUIRE, "agent");
            xb_add(&bar[XB_XGEN(b.x)], 1u);
            asm volatile("s_waitcnt vmcnt(0)" ::: "memory");
        } else {
            XB_SPIN(xb_ld(&bar[XB_XGEN(b.x)]) == gen, bar);
            __builtin_amdgcn_fence(__ATOMIC_ACQUIRE, "agent");
            asm volatile("s_waitcnt vmcnt(0)" ::: "memory");
        }
    }
    __syncthreads();
}

#ifndef MK_FILL_HOOK
#define MK_FILL_HOOK 0
#endif
#ifndef MK_EPI_RELAX
#define MK_EPI_RELAX 62
#endif
#ifndef MK_BF_ASM
#define MK_BF_ASM 0
#endif
#ifndef MK_BF_LASTPEEL
#define MK_BF_LASTPEEL 0
#endif
#ifndef MK_PRE_EARLY
#define MK_PRE_EARLY 3
#endif
#ifndef MK_EPI_PRESTAGE
#define MK_EPI_PRESTAGE 0
#endif
#ifndef MK_FILL_EARLY
#define MK_FILL_EARLY 0
#endif
#ifndef MK_FILL_ASM
#define MK_FILL_ASM ((MK_FILL_EARLY || MK_EPI_RELAX) ? 1 : 0)
#endif
#ifndef MK_TID_LAUNDER
#define MK_TID_LAUNDER 0
#endif
namespace pg8 {
constexpr int BM = 256, BK = 64, HALF = 128, HTB = HALF * BK * 2, STAGE_BYTES = 8 * HTB, NXCD = 8, WGM = 8;
__device__ __forceinline__ int lds_byte(int r, int c) { const int st = (r >> 4) * 2 + (c >> 5), rr = r & 15, cc = c & 31, ob = rr * 64 + cc * 2; return st * 1024 + (ob ^ (((ob >> 9) & 1) << 5)); }
__device__ __forceinline__ void stage_rc(int b, int& R, int& C) { const int st = b / 1024, sb = b % 1024, swz = sb ^ (((sb >> 9) & 1) << 5); R = (st >> 1) * 16 + swz / 64; C = (st & 1) * 32 + (swz % 64) / 2; }
__device__ __forceinline__ int perm32(int rho) { const int n = rho >> 4, i = rho & 15; return 8 * (i >> 2) + 4 * n + (i & 3); }

template <bool B> struct BoolC { static constexpr bool value = B; };
struct Unit { int pm, pn, aux, r0, half; };

__device__ __forceinline__ bool static_next(int nM, int nN, int G, int c, int i, int& pm, int& pn) {
    const int nwg = nM * nN; const long L = (long)i * G + c; if (L >= nwg) return false;
    int wgid = (int)L; { const int q = nwg / NXCD, r = nwg % NXCD, xcd = wgid % NXCD, off = wgid / NXCD; wgid = (xcd < r ? xcd * (q + 1) : r * (q + 1) + (xcd - r) * q) + off; }
    const int nig = WGM * nN, gid = wgid / nig, fm = gid * WGM, gsz = (nM - fm) < WGM ? (nM - fm) : WGM;
    pm = fm + ((wgid % nig) % gsz); pn = (wgid % nig) / gsz; return true;
}
__device__ __forceinline__ int xcd_remap(int L, int nwg) { const int q = nwg / NXCD, r = nwg % NXCD, xcd = L % NXCD, off = L / NXCD; return (xcd < r ? xcd * (q + 1) : r * (q + 1) + (xcd - r) * q) + off; }

typedef int v8i_t __attribute__((ext_vector_type(8)));
struct NoFill { static constexpr bool ON = false; static constexpr int NL = 2, NS = 0; template <int LO, int HI> __device__ __forceinline__ void issue_part(f32x4 (&)[2], int) const {} __device__ __forceinline__ void issue(f32x4 (&)[2], int) const {} __device__ __forceinline__ void consume(f32x4 (&)[2], int) const {} };
struct NoKFill { static constexpr bool ON = false; static constexpr int NL = 1, NS = 0; __device__ __forceinline__ void issue(f32x4 (&)[1], int) const {} __device__ __forceinline__ void consume(f32x4 (&)[1], int) const {} };
template <class Epi, class Sched, bool FP8 = false, class Fill = NoFill, class KF = NoKFill, bool HALFCAP = false, bool RELAX = false>
__device__ __forceinline__ int gemm_phase(LAS unsigned char* lds, const int RB, Sched& S, const Epi& E, const Fill& FL = Fill(), const KF& KFL = KF()) {
    int tid_ = threadIdx.x;
    if constexpr ((MK_TID_LAUNDER != 0) || (RELAX && !FP8)) asm volatile("" : "+v"(tid_));
    const int tid = tid_, wid = __builtin_amdgcn_readfirstlane(tid >> 6), lane = tid & 63, wr = wid >> 2, wc = wid & 3, fr = lane & 15, fq = lane >> 4;
    const int nt = RB / 128;
    int Rr[2], Cc[2]; unsigned voffB[2];
#pragma unroll
    for (int i = 0; i < 2; ++i) { int R, C; stage_rc(tid * 16 + i * 8192, R, C); Rr[i] = R; Cc[i] = C; const int Rb = Epi::brow(R); voffB[i] = (unsigned)(Rb * RB + C * 2); }
    const size_t kstep = (size_t)(BK * 2);
    const size_t hstep = (size_t)Epi::BHALF_ROWS * RB;
    const unsigned ldsw = (unsigned)wid * 1024u, ldsb = (unsigned)(size_t)lds;
    const int aoff = lds_byte(wr * 64 + fr, fq * 8), boff = lds_byte(wc * 32 + fr, fq * 8);
#define PG8_SA(b, h) (((b) * 2 + (h)) * HTB)
#define PG8_SB(b, h) ((4 + (b) * 2 + (h)) * HTB)
#define PG8_STAGE(bufoff, gbase, v0, v1) do { unsigned keep_; \
        asm volatile("s_mov_b32 %0, m0\n\ts_mov_b32 m0, %4\n\ts_nop 0\n\tglobal_load_lds_dwordx4 %1, %3\n\ts_add_u32 m0, m0, 0x2000\n\ts_nop 0\n\tglobal_load_lds_dwordx4 %2, %3\n\ts_mov_b32 m0, %0" \
            : "=&s"(keep_) : "v"(v0), "v"(v1), "s"((const char*)(gbase)), "s"(ldsb + (unsigned)(bufoff) + ldsw) : "memory", "scc"); } while (0)
#define PG8_STAGEB(bufoff, gbase) PG8_STAGE(bufoff, gbase, voffB[0], voffB[1])
#define PG8_LD8(addr) __builtin_shufflevector(*(const LAS u32x4*)(addr), *(const LAS u32x4*)((addr) + 1024), 0, 1, 2, 3, 4, 5, 6, 7)
#define PG8_LDA(dst, b, h) do { _Pragma("unroll") for (int m = 0; m < 4; ++m) dst[m] = PG8_LD8(lds + PG8_SA(b, h) + aoff + m * 2048); } while (0)
#define PG8_LDB(dst, b, h) do { _Pragma("unroll") for (int n = 0; n < 2; ++n) dst[n] = PG8_LD8(lds + PG8_SB(b, h) + boff + n * 2048); } while (0)
#define PG8_HALF(x, k) __builtin_bit_cast(bf16x8, __builtin_shufflevector(x, x, 4 * (k), 4 * (k) + 1, 4 * (k) + 2, 4 * (k) + 3))
#define PG8_MMA(ai, bj, At, Bt) do { __builtin_amdgcn_s_setprio(1); \
        if constexpr (!FP8 && (MK_BF_ASM != 0)) { _Pragma("unroll") for (int k_ = 0; k_ < 2; ++k_) _Pragma("unroll") for (int m = 0; m < 4; ++m) _Pragma("unroll") for (int n = 0; n < 2; ++n) { \
            const u32x4 b_ = k_ ? __builtin_shufflevector(Bt[n], Bt[n], 4, 5, 6, 7) : __builtin_shufflevector(Bt[n], Bt[n], 0, 1, 2, 3), a_ = k_ ? __builtin_shufflevector(At[m], At[m], 4, 5, 6, 7) : __builtin_shufflevector(At[m], At[m], 0, 1, 2, 3); \
            asm volatile("v_mfma_f32_16x16x32_bf16 %0, %1, %2, %0" : "+v"(acc[ai][bj][m][n]) : "v"(b_), "v"(a_)); } } else \
        _Pragma("unroll") for (int m = 0; m < 4; ++m) _Pragma("unroll") for (int n = 0; n < 2; ++n) { \
        if constexpr (FP8) { asm volatile("v_mfma_scale_f32_16x16x128_f8f6f4 %0, %1, %2, %0, %3, %4 op_sel_hi:[0,0,0]" : "+v"(acc[ai][bj][m][n]) : "v"(Bt[n]), "v"(At[m]), "v"(sc_w), "v"(sc_1)); } \
        else { acc[ai][bj][m][n] = __builtin_amdgcn_mfma_f32_16x16x32_bf16(PG8_HALF(Bt[n], 0), PG8_HALF(At[m], 0), acc[ai][bj][m][n], 0, 0, 0); \
               acc[ai][bj][m][n] = __builtin_amdgcn_mfma_f32_16x16x32_bf16(PG8_HALF(Bt[n], 1), PG8_HALF(At[m], 1), acc[ai][bj][m][n], 0, 0, 0); } } \
        __builtin_amdgcn_s_setprio(0); } while (0)
#define PG8_WAIT_V(n) asm volatile("s_waitcnt vmcnt(" #n ")" ::: "memory")
#define PG8_WAIT_VN(N) asm volatile("s_waitcnt vmcnt(%0)" :: "n"(N) : "memory")
#define PG8_WAIT_L(n) asm volatile("s_waitcnt lgkmcnt(" #n ")" ::: "memory")
#define PG8_BAR __builtin_amdgcn_s_barrier()
#define PG8_SCHED __builtin_amdgcn_sched_barrier(0)
    Unit cur, nxt; int ui = 0;
    if (!S.next(0, cur)) return 0;
    f32x4 acc[2][2][4][2];
#pragma unroll
    for (int a = 0; a < 2; ++a)
#pragma unroll
        for (int b = 0; b < 2; ++b)
#pragma unroll
            for (int m = 0; m < 4; ++m)
#pragma unroll
                for (int n = 0; n < 2; ++n) acc[a][b][m][n] = (f32x4){0.f, 0.f, 0.f, 0.f};
    typedef unsigned u32x8 __attribute__((ext_vector_type(8)));
    u32x8 At[4], B0[2], B1[2];
    f32x4 ff[Fill::NL];
    constexpr bool LP = (RELAX && (FP8 || (MK_BF_ASM != 0)) && (MK_PRE_EARLY != 0)) || ((MK_BF_LASTPEEL != 0) && !FP8 && !RELAX && Fill::ON && !KF::ON);
    constexpr bool PRE = RELAX && (MK_EPI_PRESTAGE != 0);
    constexpr int EA_ = (Fill::ON ? Fill::NL + Fill::NS : 0) + Epi::VM_MIN, EA = EA_ > 55 ? 55 : EA_;
    f32x4 kf[KF::NL]; int kfi = 0;
    const unsigned sc_w = 0x77777777u, sc_1 = 0x7f7f7f7fu;
    if (Sched::GATHER) { S.pre(cur, 0); PG8_WAIT_V(0); __syncthreads(); }
    unsigned vc[2][2];
    S.a_voff(cur, 0, vc, Rr, Cc, RB);
    const char* cA = S.a_base(cur); const char* cB = S.b_base(cur);
    PG8_STAGEB(PG8_SB(0, 0), cB); PG8_STAGEB(PG8_SB(0, 1), cB + hstep); PG8_STAGE(PG8_SA(0, 0), cA, vc[0][0], vc[0][1]); PG8_STAGE(PG8_SA(0, 1), cA, vc[1][0], vc[1][1]);
    if (wr == 1) PG8_BAR;
    PG8_WAIT_V(2); PG8_BAR;
    PG8_STAGEB(PG8_SB(1, 0), cB + kstep); PG8_STAGE(PG8_SA(1, 0), cA + kstep, vc[0][0], vc[0][1]); PG8_STAGEB(PG8_SB(1, 1), cB + hstep + kstep);
    if constexpr (PRE) PG8_STAGE(PG8_SA(1, 1), cA + kstep, vc[1][0], vc[1][1]);
    if constexpr (KF::ON || RELAX) PG8_WAIT_V(0); else PG8_WAIT_V(6);
    PG8_BAR;
    for (;;) {
        const bool has_next = S.next(ui + 1, nxt);
        const bool hf = HALFCAP && cur.half != 0;
        const char* nA = has_next ? S.a_base(nxt) : cA; const char* nB = has_next ? S.b_base(nxt) : cB;
#define PG8_KITER(T_, FE_, LE_) do { const int t = (T_); \
            const bool last = (t == nt - 2); \
            constexpr bool fe = RELAX && !KF::ON && (FE_); \
            if (Sched::GATHER) { if (t == nt - 4 && has_next) S.pre(nxt, ui + 1); } \
            unsigned vs[2][2]; \
_Pragma("unroll") \
            for (int h = 0; h < 2; ++h) \
_Pragma("unroll") \
                for (int i = 0; i < 2; ++i) vs[h][i] = vc[h][i]; \
            if (Sched::GATHER) { if (last && has_next) S.a_voff(nxt, ui + 1, vs, Rr, Cc, RB); } \
            const char* a1 = cA + (size_t)(t + 1) * kstep; \
            const char* a2 = last ? nA : cA + (size_t)(t + 2) * kstep; const char* b2 = last ? nB : cB + (size_t)(t + 2) * kstep; \
            const char* a3 = a2 + kstep; const char* b3 = b2 + kstep; \
            PG8_LDB(B0, 0, 0); PG8_LDB(B1, 0, 1); PG8_SCHED; PG8_LDA(At, 0, 0); if constexpr (!(fe && PRE)) PG8_STAGE(PG8_SA(1, 1), a1, vc[1][0], vc[1][1]); \
            if constexpr (fe) PG8_WAIT_VN(8 + EA); else PG8_WAIT_VN(8 + KF::NS); \
            PG8_WAIT_L(0); PG8_BAR; if constexpr (KF::ON) KFL.issue(kf, kfi); PG8_MMA(0, 0, At, B0); PG8_MMA(0, 1, At, B1); PG8_BAR; PG8_SCHED; \
            if (!hf) PG8_LDA(At, 0, 1); PG8_STAGEB(PG8_SB(0, 0), b2); PG8_STAGEB(PG8_SB(0, 1), b2 + hstep); PG8_STAGE(PG8_SA(0, 0), a2, vs[0][0], vs[0][1]); \
            if constexpr (fe) PG8_WAIT_VN(8 + EA); else PG8_WAIT_VN(8 + KF::NS + (KF::ON ? KF::NL : 0)); \
            PG8_WAIT_L(0); PG8_BAR; if (!hf) { PG8_MMA(1, 0, At, B0); PG8_MMA(1, 1, At, B1); } PG8_BAR; PG8_SCHED; \
            PG8_LDB(B0, 1, 0); PG8_LDB(B1, 1, 1); PG8_SCHED; PG8_LDA(At, 1, 0); PG8_STAGE(PG8_SA(0, 1), a2, vs[1][0], vs[1][1]); \
            if constexpr (fe && PRE) PG8_WAIT_VN(8 + EA); else PG8_WAIT_VN(8 + (KF::ON ? KF::NL : 0)); \
            PG8_WAIT_L(0); PG8_BAR; PG8_MMA(0, 0, At, B0); PG8_MMA(0, 1, At, B1); PG8_BAR; PG8_SCHED; \
            if (!hf) PG8_LDA(At, 1, 1); PG8_STAGEB(PG8_SB(1, 0), b3); PG8_STAGEB(PG8_SB(1, 1), b3 + hstep); PG8_STAGE(PG8_SA(1, 0), a3, vs[0][0], vs[0][1]); \
            if constexpr (KF::ON) { static_assert(KF::NL == 4, "kf tie"); asm volatile("s_waitcnt vmcnt(8)" : "+v"(kf[0]), "+v"(kf[1]), "+v"(kf[2]), "+v"(kf[3]) :: "memory"); } else PG8_WAIT_V(8); \
            PG8_WAIT_L(0); PG8_BAR; if constexpr (LP && (LE_)) { E.preload(epre, cur, wc, fq); if constexpr (Fill::ON && (MK_PRE_EARLY >= 2)) FL.template issue_part<0, (MK_PRE_EARLY == 2 ? Fill::NL : Fill::NL / 2)>(ff, ui); } \
            if (!hf) PG8_MMA(1, 0, At, B0); if constexpr (KF::ON) { KFL.consume(kf, kfi); ++kfi; } \
            if constexpr (LP && (LE_) && Fill::ON && (MK_PRE_EARLY == 4)) FL.template issue_part<Fill::NL / 2, Fill::NL>(ff, ui); \
            if (!hf) PG8_MMA(1, 1, At, B1); PG8_BAR; PG8_SCHED; \
            if (Sched::GATHER) { if (last) { \
_Pragma("unroll") \
                for (int h = 0; h < 2; ++h) \
_Pragma("unroll") \
                    for (int i = 0; i < 2; ++i) vc[h][i] = vs[h][i]; } } \
        } while (0)
        typename Epi::Pre epre;
        if constexpr (LP && !RELAX) { for (int t_ = 0; t_ < nt - 2; t_ += 2) PG8_KITER(t_, false, false); PG8_KITER(nt - 2, false, true); }
        else if constexpr (LP) { PG8_KITER(0, true, false); for (int t_ = 2; t_ < nt - 2; t_ += 2) PG8_KITER(t_, false, false); PG8_KITER(nt - 2, false, true); }
        else if constexpr (RELAX) { PG8_KITER(0, true, false); for (int t_ = 2; t_ < nt; t_ += 2) PG8_KITER(t_, false, false); }
        else { for (int t_ = 0; t_ < nt; t_ += 2) PG8_KITER(t_, false, false); }
#undef PG8_KITER
        if (wr == 0) PG8_BAR;
        if constexpr (PRE) { if (has_next) PG8_STAGE(PG8_SA(1, 1), nA + kstep, vc[1][0], vc[1][1]); }
        if constexpr (FP8 || (MK_BF_ASM != 0)) asm volatile("s_nop 15\n\ts_nop 15\n\ts_nop 15\n\ts_nop 15" ::: "memory");
        if constexpr (!LP) E.preload(epre, cur, wc, fq);
        if constexpr (Fill::ON && LP && (MK_PRE_EARLY == 3)) FL.template issue_part<Fill::NL / 2, Fill::NL>(ff, ui);
        else if constexpr (Fill::ON && !(LP && (MK_PRE_EARLY == 2 || MK_PRE_EARLY == 4))) FL.issue(ff, ui);
        epre.template ready<(Fill::ON && (MK_FILL_ASM != 0)) ? Fill::NL : 0>();
        const bool keep = E(acc, cur, wr, wc, fr, fq, epre);
#if MK_FILL_ASM
        if constexpr (Fill::ON) FL.template consume_w<Epi::VM_MIN>(ff, ui);
#else
        if constexpr (Fill::ON) FL.consume(ff, ui);
#endif
        if (!has_next) break;
        if (!keep) {
#pragma unroll
            for (int a = 0; a < 2; ++a)
#pragma unroll
                for (int b = 0; b < 2; ++b)
#pragma unroll
                    for (int m = 0; m < 4; ++m)
#pragma unroll
                        for (int n = 0; n < 2; ++n) acc[a][b][m][n] = (f32x4){0.f, 0.f, 0.f, 0.f};
        }
        cur = nxt; cA = nA; cB = nB; ++ui;
        if (wr == 1) PG8_BAR;
    }
    PG8_WAIT_V(0);
    PG8_BAR;
    return kfi;
#undef PG8_SA
#undef PG8_SB
#undef PG8_STAGE
#undef PG8_STAGEB
#undef PG8_LDA
#undef PG8_LDB
#undef PG8_MMA
#undef PG8_HALF
#undef PG8_LD8
#undef PG8_WAIT_V
#undef PG8_WAIT_VN
#undef PG8_WAIT_L
#undef PG8_BAR
#undef PG8_SCHED
}
}

constexpr int D = 2048, NTOK = 16384, TSEQ = 2048, NBATCH = 8, DIN = 12320, NE = 32, NZ = 12288;
constexpr int Z_HQ = 0, Z_HFF = 1024, Z_HFB = 2048, Z_HI = 3072, Z_HOG = 4096, Z_GQ = 5120, Z_GK = 5632, Z_GV = 6144, Z_GR = 7168, Z_MGA = 8192, Z_MGB = 10240;
constexpr float RMS_EPS = 1e-5f, QSCALE = 0.08838834764831845f;
constexpr int NWAVES = 8, NTHREADS = 512;
#ifndef MK_FP8
#define MK_FP8 1
#endif
constexpr int MOE_RB = MK_FP8 ? D : 2 * D;
#ifndef MK_GU_IN_P2
#define MK_GU_IN_P2 1
#endif
#ifndef MK_GU_KFILL
#define MK_GU_KFILL 0
#endif
#if MK_GU_KFILL
#undef MK_GU_IN_P2
#define MK_GU_IN_P2 0
#endif
#ifndef MK_GU_SPLIT
#define MK_GU_SPLIT 16
#endif
#ifndef MK_GU_PROBE
#define MK_GU_PROBE 0
#endif
#ifndef MK_GU_P2_SKIP
#define MK_GU_P2_SKIP 0
#endif
#ifndef MK_FP8_MG
#define MK_FP8_MG 1
#endif
constexpr size_t MiB = 1u << 20;
constexpr size_t WS_CTL = 0, CTL_ZERO_BYTES = 1 * MiB;
constexpr size_t WS_LB = 1 * MiB, WS_W2T = 1 * MiB + 65536, WS_WLRT = 1 * MiB + 131072;
constexpr size_t WS_WINT = 2 * MiB, WS_WPAT = 50 * MiB, WS_WPBT = 54 * MiB, WS_WOUTT = 58 * MiB, WS_WGUT = 66 * MiB, WS_WDNT = 578 * MiB;
constexpr size_t WS_XN = 834 * MiB, WS_ZB = 898 * MiB, WS_GGLA = 1282 * MiB, WS_OBUF = 1314 * MiB, WS_YA = 1442 * MiB, WS_YB = 1474 * MiB, WS_MERGED = 1506 * MiB, WS_H1 = 1570 * MiB;
constexpr size_t WS_ROWTOK = 1698 * MiB, WS_ROWW = 1700 * MiB, WS_PAIR = 1702 * MiB, WS_ACT = 1704 * MiB, WS_YPAIR = 1992 * MiB, WS_OBUF2 = 2280 * MiB, WS_XN8 = 2344 * MiB, WS_END = 2408 * MiB;
#ifndef MK_FP8_PO
#define MK_FP8_PO 1
#endif
#ifndef MK_FP8_VG
#define MK_FP8_VG (MK_FP8_PO ? 0 : 1)
#endif
#if 0
#endif
#ifndef MK_G8
#define MK_G8 1
#endif
constexpr size_t WS_G8 = WS_END + 24 * MiB;
constexpr size_t WS_WINT8 = MK_FP8_VG ? WS_END : WS_WINT + 32 * MiB;
constexpr int CW_BAR = 4096, CW_ECNT = 8192;
constexpr int RING_BYTES = 131072, LDS_XB = RING_BYTES, LDS_LIST = RING_BYTES + 64, LDS_TAB = LDS_LIST + 2048, LDS_BYTES = 147456;
static_assert(LDS_TAB + 4 * (128 + 320) <= LDS_BYTES, "lds map");

struct Params { const float* in[19]; float* out; unsigned char* ws; };
struct Frame {
    LAS unsigned char* lds; int tid, lane, wave, vcu, G;
    const float *x, *norm1_g, *w_in, *lb_logits, *hg_norm_g, *gla_w2, *gla_b, *gla_norm_g, *w_proj_a, *w_proj_b, *w_out, *norm2_g, *router_w, *router_b, *w_gate_up, *b_gate_up, *w_down, *b_down, *final_g;
    float* out; unsigned char* ws; unsigned* ctl;
};
#define WSP(T, off) ((T*)(F.ws + (off)))

#ifndef MK_VG_MASK
#define MK_VG_MASK 15
#endif
__device__ __forceinline__ constexpr bool in_tile_is_f8(int t) { return t >= 32 || (MK_FP8_VG && (((MK_VG_MASK & 1) && t >= 12 && t < 16) || ((MK_VG_MASK & 2) && t >= 16 && t < 20) || ((MK_VG_MASK & 4) && t >= 24 && t < 28) || ((MK_VG_MASK & 8) && t >= 28 && t < 32))); }
__device__ __forceinline__ constexpr int in_tiles_f8() { int n = 0; for (int t = 0; t < 48; ++t) n += in_tile_is_f8(t) ? 1 : 0; return n; }
__device__ __forceinline__ int in_nth_tile(int j, bool f8) { int t = 0, k = -1;
#pragma unroll 1
    for (; t < 48; ++t) { if (in_tile_is_f8(t) == f8) { if (++k == j) break; } } return t; }
struct InSched {
    static constexpr bool GATHER = false;
    const void* A; const void* Bt; int nM, nN, G, c, RB, f8;
    __device__ __forceinline__ bool next(int i, pg8::Unit& u) const { u.aux = 0; u.r0 = 0; u.half = 0; const bool ok = pg8::static_next(nM, nN, G, c, i, u.pm, u.pn);
        if (MK_FP8_VG && MK_VG_MASK == 15) u.pn = f8 ? (u.pn < 8 ? u.pn + 12 : u.pn + 16) : (u.pn < 12 ? u.pn : u.pn + 8); else if (MK_FP8_VG) u.pn = in_nth_tile(u.pn, f8 != 0); else u.pn = f8 ? u.pn + 32 : u.pn;
        return ok; }
    __device__ __forceinline__ const char* a_base(const pg8::Unit& u) const { return (const char*)A + (size_t)u.pm * 256 * RB; }
    __device__ __forceinline__ const char* b_base(const pg8::Unit& u) const { return (const char*)Bt + (size_t)u.pn * 256 * RB; }
    __device__ __forceinline__ void a_voff(const pg8::Unit&, int, unsigned (&vo)[2][2], const int (&R)[2], const int (&C)[2], int K_) const {
#pragma unroll
        for (int h = 0; h < 2; ++h)
#pragma unroll
            for (int i = 0; i < 2; ++i) vo[h][i] = (unsigned)((h * 128 + R[i]) * K_ + C[i] * 2); }
    __device__ __forceinline__ void pre(const pg8::Unit&, int) const {}
};
struct DenseSched {
    static constexpr bool GATHER = false;
    const void* A; const void* Bt; int nM, nN, G, c, RB;
    __device__ __forceinline__ bool next(int i, pg8::Unit& u) const { u.aux = 0; u.r0 = 0; u.half = 0; return pg8::static_next(nM, nN, G, c, i, u.pm, u.pn); }
    __device__ __forceinline__ const char* a_base(const pg8::Unit& u) const { return (const char*)A + (size_t)u.pm * 256 * RB; }
    __device__ __forceinline__ const char* b_base(const pg8::Unit& u) const { return (const char*)Bt + (size_t)u.pn * 256 * RB; }
    __device__ __forceinline__ void a_voff(const pg8::Unit&, int, unsigned (&vo)[2][2], const int (&R)[2], const int (&C)[2], int K_) const {
#pragma unroll
        for (int h = 0; h < 2; ++h)
#pragma unroll
            for (int i = 0; i < 2; ++i) vo[h][i] = (unsigned)((h * 128 + R[i]) * K_ + C[i] * 2); }
    __device__ __forceinline__ void pre(const pg8::Unit&, int) const {}
};
struct MergeSched {
    static constexpr bool GATHER = false;
    const bf16_t *A0, *B0; long dA, dB; int nM, nN, G, c, RB;
    __device__ __forceinline__ bool next(int i, pg8::Unit& u) const { u.aux = i & 1; u.r0 = 0; u.half = 0; return pg8::static_next(nM, nN, G, c, i >> 1, u.pm, u.pn); }
    __device__ __forceinline__ const char* a_base(const pg8::Unit& u) const { return (const char*)A0 + (size_t)u.aux * dA + (size_t)u.pm * 256 * RB; }
    __device__ __forceinline__ const char* b_base(const pg8::Unit& u) const { return (const char*)B0 + (size_t)u.aux * dB + (size_t)u.pn * 256 * RB; }
    __device__ __forceinline__ void a_voff(const pg8::Unit&, int, unsigned (&vo)[2][2], const int (&R)[2], const int (&C)[2], int K_) const {
#pragma unroll
        for (int h = 0; h < 2; ++h)
#pragma unroll
            for (int i = 0; i < 2; ++i) vo[h][i] = (unsigned)((h * 128 + R[i]) * K_ + C[i] * 2); }
    __device__ __forceinline__ void pre(const pg8::Unit&, int) const {}
};
#ifndef MK_TAIL_SPLIT
#define MK_TAIL_SPLIT 1
#endif
#ifndef MK_HALF_TILES
#define MK_HALF_TILES 0
#endif
constexpr int TAB_NMF = 448, TAB_TBF = 480, TAB_NTF = 516, TAB_NTH = 517, TAB_HIDX = 520, TAB_EOF = 560;
static_assert(LDS_TAB + 4 * (TAB_EOF + 320) <= LDS_BYTES, "lds map (half tiles)");
__device__ __forceinline__ int tabr(const volatile LAS int* tab, int i) { return __builtin_amdgcn_readfirstlane(tab[i]); }
__device__ __forceinline__ int tab_expert_of_tile(const volatile LAS int* tab, int Tt) { return tabr(tab, 128 + Tt); }
struct GuSched {
    static constexpr bool GATHER = true;
    const void* A; const void* Bt; const int* rowtok; const volatile LAS int* tab; LAS unsigned char* lds; int G, c, RB, tid;
    __device__ __forceinline__ bool next(int i, pg8::Unit& u) const {
#if MK_HALF_TILES
        const int NTF = tabr(tab, TAB_NTF), nwgF = NTF * 16; const long L = (long)i * G + c;
        if (L < nwgF) { const int w = pg8::xcd_remap((int)L, nwgF); const int e = tabr(tab, TAB_EOF + (w >> 4));
            const int tbF = tabr(tab, TAB_TBF + e), local = w - 16 * tbF, nm = tabr(tab, TAB_NMF + e);
            u.pm = local % nm; u.pn = local / nm; u.aux = e; u.r0 = (tabr(tab, 64 + e) + u.pm) * 256; u.half = 0; return true; }
        const long Lh = L - nwgF; if (Lh >= (long)tabr(tab, TAB_NTH) * 16) return false;
        { const int e = tabr(tab, TAB_HIDX + (int)(Lh >> 4)); u.pm = tabr(tab, 32 + e) - 1; u.pn = (int)(Lh & 15); u.aux = e; u.r0 = (tabr(tab, 64 + e) + u.pm) * 256; u.half = 1; return true; }
#else
        const int NTt = tabr(tab, 100), nwg = NTt * 16; const long L = (long)i * G + c; if (L >= nwg) return false;
        const int w = pg8::xcd_remap((int)L, nwg);
        const int Tt = w >> 4; int e = tab_expert_of_tile(tab, Tt);
        const int tb = tabr(tab, 64 + e), local = w - 16 * tb, nm = tabr(tab, 32 + e);
        u.pm = local % nm; u.pn = local / nm; u.aux = e; u.r0 = (tb + u.pm) * 256; u.half = 0; return true;
#endif
    }
    __device__ __forceinline__ const char* a_base(const pg8::Unit&) const { return (const char*)A; }
    __device__ __forceinline__ const char* b_base(const pg8::Unit& u) const { return (const char*)Bt + ((size_t)u.aux * 4096 + (size_t)u.pn * 256) * RB; }
    __device__ __forceinline__ void pre(const pg8::Unit& u, int slot) const {
        if (tid < 256) __builtin_amdgcn_global_load_lds((const unsigned*)(rowtok + (size_t)u.aux * NTOK + u.pm * 256 + tid), (LAS unsigned*)(lds + LDS_LIST + (slot & 1) * 1024 + (tid >> 6) * 256), 4, 0, 0); }
    __device__ __forceinline__ void a_voff(const pg8::Unit& u, int slot, unsigned (&vo)[2][2], const int (&R)[2], const int (&C)[2], int K_) const {
        const volatile LAS int* lst = (const volatile LAS int*)(lds + LDS_LIST + (slot & 1) * 1024); const int n = tabr(tab, u.aux);
#pragma unroll
        for (int h = 0; h < 2; ++h)
#pragma unroll
            for (int i = 0; i < 2; ++i) { const int r = h * 128 + R[i]; int tok = lst[r]; if (u.pm * 256 + r >= n) tok = 0; vo[h][i] = (unsigned)(tok * K_ + C[i] * 2); } }
};
struct DownSched {
    static constexpr bool GATHER = false;
    const void* A; const void* Bt; const volatile LAS int* tab; int G, c, RB;
    __device__ __forceinline__ bool next(int i, pg8::Unit& u) const {
#if MK_HALF_TILES
        const int NTF = tabr(tab, TAB_NTF); int pf;
        if (pg8::static_next(NTF, 8, G, c, i, pf, u.pn)) { const int e = tabr(tab, TAB_EOF + pf); const int lp = pf - tabr(tab, TAB_TBF + e); u.pm = tabr(tab, 64 + e) + lp; u.aux = e; u.r0 = lp * 256; u.half = 0; return true; }
        const long Lh = (long)i * G + c - (long)NTF * 8; if (Lh < 0 || Lh >= (long)tabr(tab, TAB_NTH) * 8) return false;
        { const int e = tabr(tab, TAB_HIDX + (int)(Lh >> 3)); const int lp = tabr(tab, 32 + e) - 1; u.pm = tabr(tab, 64 + e) + lp; u.pn = (int)(Lh & 7); u.aux = e; u.r0 = lp * 256; u.half = 1; return true; }
#else
        const int NTt = tabr(tab, 100); u.half = 0;
#if MK_TAIL_SPLIT
        { const int U = NTt * 8, full = U / G, rem = U - full * G;
          if (i == full && rem > 0 && 2 * rem <= G) { if (c >= 2 * rem) return false;
              if (!pg8::static_next(NTt, 8, 1, full * G + (c >> 1), 0, u.pm, u.pn)) return false;
              u.half = 1 + (c & 1); const int e = tab_expert_of_tile(tab, u.pm); u.aux = e; u.r0 = (u.pm - tabr(tab, 64 + e)) * 256; return true; } }
#endif
        if (!pg8::static_next(NTt, 8, G, c, i, u.pm, u.pn)) return false;
        const int e = tab_expert_of_tile(tab, u.pm); u.aux = e; u.r0 = (u.pm - tabr(tab, 64 + e)) * 256; return true;
#endif
    }
    __device__ __forceinline__ const char* a_base(const pg8::Unit& u) const { return (const char*)A + ((size_t)u.pm * 256 + (u.half == 2 ? 128 : 0)) * RB; }
    __device__ __forceinline__ const char* b_base(const pg8::Unit& u) const { return (const char*)Bt + ((size_t)u.aux * 2048 + (size_t)u.pn * 256) * RB; }
    __device__ __forceinline__ void a_voff(const pg8::Unit&, int, unsigned (&vo)[2][2], const int (&R)[2], const int (&C)[2], int K_) const {
#pragma unroll
        for (int h = 0; h < 2; ++h)
#pragma unroll
            for (int i = 0; i < 2; ++i) vo[h][i] = (unsigned)((h * 128 + R[i]) * K_ + C[i] * 2); }
    __device__ __forceinline__ void pre(const pg8::Unit&, int) const {}
};

#ifndef MK_ROWS64
#define MK_ROWS64 1
#endif
#define ROWS_64    static constexpr int BHALF_ROWS = 32;  static __device__ __forceinline__ int brow(int R) { return 64 * (R >> 5) + 8 * ((R >> 2) & 3) + 4 * ((R >> 4) & 1) + (R & 3); }
#define ROWS_GU    static constexpr int BHALF_ROWS = 8;   static __device__ __forceinline__ int brow(int R) { return 64 * (R >> 5) + 16 * ((R >> 2) & 3) + 4 * ((R >> 4) & 1) + (R & 3); }
#ifndef MK_PK_EPI
#define MK_PK_EPI 1
#endif
#ifndef MK_SILU_P3
#define MK_SILU_P3 0
#endif
template <bool P64>
struct EpiInProjT {
    struct Pre { template <int NAFTER> __device__ __forceinline__ void ready() {} }; __device__ __forceinline__ void preload(Pre&, const pg8::Unit&, int, int) const {}
    static constexpr int BHALF_ROWS = P64 ? 32 : 8;
    static __device__ __forceinline__ int brow(int R) { return 64 * (R >> 5) + (P64 ? 8 : 16) * ((R >> 2) & 3) + 4 * ((R >> 4) & 1) + (R & 3); }
    static constexpr int BJS = P64 ? 32 : 8, FQS = P64 ? 8 : 16;
    static constexpr int VM_MIN = (MK_G8 && !P64) ? 8 : 32;
    bf16_t* Z; const float* lb; int coloff; unsigned char* g8;
    template <int KIND> __device__ __forceinline__ void run(f32x4 (&acc)[2][2][4][2], int row0, int col0, float sc) const {
        float lbv[2][8];
        if (KIND == 3) {
#pragma unroll
            for (int bj = 0; bj < 2; ++bj) { const f32x4 a = *(const f32x4*)(lb + col0 - 1024 + bj * BJS), b = *(const f32x4*)(lb + col0 - 1024 + bj * BJS + 4);
                lbv[bj][0] = a[0]; lbv[bj][1] = a[1]; lbv[bj][2] = a[2]; lbv[bj][3] = a[3]; lbv[bj][4] = b[0]; lbv[bj][5] = b[1]; lbv[bj][6] = b[2]; lbv[bj][7] = b[3]; }
        }
        if (KIND == 2 && MK_G8) { static_assert(!P64 || !MK_G8 || KIND != 2 || true, "");
#pragma unroll
            for (int ai = 0; ai < 2; ++ai)
#pragma unroll
                for (int m = 0; m < 4; ++m) { unsigned w[4];
#pragma unroll
                    for (int q = 0; q < 4; ++q) { const f32x4 a = acc[ai][q >> 1][m][q & 1]; unsigned t = 0u;
#if MK_PK_EPI
                        const f32x2 s0 = sigm2k((f32x2){a[0], a[1]}, -1.4426950408889634f) * (f32x2){255.f, 255.f}, s1 = sigm2k((f32x2){a[2], a[3]}, -1.4426950408889634f) * (f32x2){255.f, 255.f};
                        const float sv[4] = {s0.x, s0.y, s1.x, s1.y};
#pragma unroll
                        for (int j = 0; j < 4; ++j) t = __builtin_amdgcn_cvt_pk_u8_f32(fmaxf(__builtin_rintf(sv[j]), 1.f), (unsigned)j, t);
#else
#pragma unroll
                        for (int j = 0; j < 4; ++j) t = __builtin_amdgcn_cvt_pk_u8_f32(fmaxf(__builtin_rintf(fsigm(a[j]) * 255.f), 1.f), (unsigned)j, t);
#endif
                        w[q] = t; }
                    *(u32x4*)(g8 + (size_t)(row0 + ai * 128 + m * 16) * 4096 + (col0 - Z_MGA)) = (u32x4){w[0], w[1], w[2], w[3]}; }
            return; }
#pragma unroll
        for (int ai = 0; ai < 2; ++ai)
#pragma unroll
            for (int m = 0; m < 4; ++m) { bf16_t* rowp = Z + (size_t)(row0 + ai * 128 + m * 16) * NZ + col0;
#pragma unroll
                for (int bj = 0; bj < 2; ++bj) { float v[8];
#pragma unroll
                    for (int j = 0; j < 4; ++j) { v[j] = acc[ai][bj][m][0][j]; v[4 + j] = acc[ai][bj][m][1][j]; }
#if MK_PK_EPI
#pragma unroll
                    for (int j = 0; j < 8; j += 2) { f32x2 x = {v[j], v[j + 1]};
                        if (KIND == 0) x = x * (f32x2){sc, sc};
                        else if (KIND == 1) x = (x * (f32x2){sc, sc}) * sigm2k(x, -1.4426950408889634f);
                        else if (KIND == 2) x = sigm2k(x, -1.4426950408889634f);
                        else { const f32x2 l = {lbv[bj][j], lbv[bj][j + 1]}; const f32x2 t = l + ((f32x2){1.f, 1.f} - l) * sigm2k(x, -1.4426950408889634f);
                            x = (f32x2){__builtin_amdgcn_logf(t.x), __builtin_amdgcn_logf(t.y)} * (f32x2){0.6931471805599453f, 0.6931471805599453f}; }
                        v[j] = x.x; v[j + 1] = x.y; }
#else
#pragma unroll
                    for (int j = 0; j < 8; ++j) {
                        if (KIND == 0) v[j] *= sc;
                        else if (KIND == 1) v[j] = v[j] * fsigm(v[j]) * sc;
                        else if (KIND == 2) v[j] = fsigm(v[j]);
                        else { const float l = lbv[bj][j]; v[j] = __logf(l + (1.f - l) * fsigm(v[j])); }
                    }
#endif
                    u32x4 w; w.x = cvt_pk_bf16(v[0], v[1]); w.y = cvt_pk_bf16(v[2], v[3]); w.z = cvt_pk_bf16(v[4], v[5]); w.w = cvt_pk_bf16(v[6], v[7]);
                    *(u32x4*)(rowp + bj * BJS) = w; } }
    }
    __device__ __forceinline__ bool operator()(f32x4 (&acc)[2][2][4][2], const pg8::Unit& u, int wr, int wc, int fr, int fq, const Pre&) const {
        const int colt = coloff + u.pn * 256; int kind; float sc = 1.f;
        if (colt < Z_HFF) { kind = 1; sc = QSCALE; } else if (colt < Z_HI) kind = 3; else if (colt < Z_HOG) kind = 0; else if (colt < Z_GQ) kind = MK_SILU_P3 ? 0 : 1;
        else if (colt < Z_GK) { kind = 0; sc = QSCALE; } else if (colt < Z_GR) kind = 0; else if (colt < Z_MGA) kind = MK_SILU_P3 ? 0 : 1; else kind = 2;
        const int row0 = u.pm * 256 + wr * 64 + fr, col0 = colt + wc * 64 + FQS * fq;
        if (kind == 0) run<0>(acc, row0, col0, sc); else if (kind == 1) run<1>(acc, row0, col0, sc); else if (kind == 2) run<2>(acc, row0, col0, sc); else run<3>(acc, row0, col0, sc);
        return false;
    }
};
typedef EpiInProjT<false> EpiInProj;

struct EpiMerge {
    struct Pre { template <int NAFTER> __device__ __forceinline__ void ready() {} }; __device__ __forceinline__ void preload(Pre&, const pg8::Unit&, int, int) const {}
    ROWS_GU
    static constexpr int VM_MIN = (MK_G8 && MK_FP8_PO) ? 8 : 8;
    const bf16_t* Z; bf16_t* O; const unsigned char* g8;
#if MK_G8 && MK_FP8_PO
    static __device__ __forceinline__ void dec16(const u32x4 g, float (&f)[16]) {
        const unsigned w[4] = {g.x, g.y, g.z, g.w};
#pragma unroll
        for (int q = 0; q < 4; ++q)
#pragma unroll
            for (int j = 0; j < 4; ++j) f[4 * q + j] = (float)((w[q] >> (8 * j)) & 0xffu) * (1.f / 255.f); }
    __device__ __forceinline__ void seg0(f32x4 (&acc)[2][2][4][2], int row0, int col0) const {
#pragma unroll
        for (int ai = 0; ai < 2; ++ai)
#pragma unroll
            for (int mp = 0; mp < 2; ++mp) { u32x4 ga[2], gb[2];
#pragma unroll
                for (int mm = 0; mm < 2; ++mm) { const unsigned char* gp = g8 + (size_t)(row0 + ai * 128 + (2 * mp + mm) * 16) * 4096 + col0; ga[mm] = *(const u32x4*)gp; gb[mm] = *(const u32x4*)(gp + 2048); }
#pragma unroll
                for (int mm = 0; mm < 2; ++mm) { const int m = 2 * mp + mm; float sa[16], sb[16]; dec16(ga[mm], sa); dec16(gb[mm], sb);
#pragma unroll
                    for (int bj = 0; bj < 2; ++bj)
#pragma unroll
                        for (int n = 0; n < 2; ++n)
#pragma unroll
                            for (int j = 0; j < 4; ++j) acc[ai][bj][m][n][j] *= sa[8 * bj + 4 * n + j] * __builtin_amdgcn_rcpf(sb[8 * bj + 4 * n + j]); } } }
    __device__ __forceinline__ void seg1(f32x4 (&acc)[2][2][4][2], int row0, int col0) const {
#pragma unroll
        for (int ai = 0; ai < 2; ++ai) { u32x4 gb[4];
#pragma unroll
            for (int m = 0; m < 4; ++m) gb[m] = *(const u32x4*)(g8 + (size_t)(row0 + ai * 128 + m * 16) * 4096 + 2048 + col0);
#pragma unroll
            for (int m = 0; m < 4; ++m) { float sb[16]; dec16(gb[m], sb); unsigned w[4];
#pragma unroll
                for (int q = 0; q < 4; ++q) { const f32x4 a = acc[ai][q >> 1][m][q & 1];
                    const unsigned t = __builtin_amdgcn_cvt_pk_fp8_f32(a[0] * sb[4 * q], a[1] * sb[4 * q + 1], 0u, false); w[q] = __builtin_amdgcn_cvt_pk_fp8_f32(a[2] * sb[4 * q + 2], a[3] * sb[4 * q + 3], t, true); }
                *(u32x4*)((unsigned char*)O + (size_t)(row0 + ai * 128 + m * 16) * D + col0) = (u32x4){w[0], w[1], w[2], w[3]}; } } }
    __device__ __forceinline__ bool operator()(f32x4 (&acc)[2][2][4][2], const pg8::Unit& u, int wr, int wc, int fr, int fq, const Pre&) const {
        const int row0 = u.pm * 256 + wr * 64 + fr, col0 = u.pn * 256 + wc * 64 + 16 * fq; const bool first = (u.aux == 0);
        if (first) seg0(acc, row0, col0); else seg1(acc, row0, col0);
        return first;
    }
#else
    __device__ __forceinline__ bool operator()(f32x4 (&acc)[2][2][4][2], const pg8::Unit& u, int wr, int wc, int fr, int fq) const {
        const int row0 = u.pm * 256 + wr * 64 + fr, col0 = u.pn * 256 + wc * 64 + 16 * fq; const bool first = (u.aux == 0);
#pragma unroll
        for (int ai = 0; ai < 2; ++ai)
#pragma unroll
            for (int m = 0; m < 4; ++m) { const size_t r = (size_t)(row0 + ai * 128 + m * 16);
#pragma unroll
                for (int bj = 0; bj < 2; ++bj) {
#if MK_G8
                    const u32x2 gb = *(const u32x2*)(g8 + r * 4096 + 2048 + col0 + bj * 8); float sb[8];
#pragma unroll
                    for (int j = 0; j < 4; ++j) { sb[j] = (float)((gb.x >> (8 * j)) & 0xffu) * (1.f / 255.f); sb[4 + j] = (float)((gb.y >> (8 * j)) & 0xffu) * (1.f / 255.f); }
#else
                    const u32x4 gb = *(const u32x4*)(Z + r * NZ + Z_MGB + col0 + bj * 8);
                    float sb[8] = {bf_lo(gb.x), bf_hi(gb.x), bf_lo(gb.y), bf_hi(gb.y), bf_lo(gb.z), bf_hi(gb.z), bf_lo(gb.w), bf_hi(gb.w)};
#endif
                    if (first) {
#if MK_G8
                        const u32x2 ga = *(const u32x2*)(g8 + r * 4096 + col0 + bj * 8); float sa[8];
#pragma unroll
                        for (int j = 0; j < 4; ++j) { sa[j] = (float)((ga.x >> (8 * j)) & 0xffu) * (1.f / 255.f); sa[4 + j] = (float)((ga.y >> (8 * j)) & 0xffu) * (1.f / 255.f); }
#else
                        const u32x4 ga = *(const u32x4*)(Z + r * NZ + Z_MGA + col0 + bj * 8);
                        float sa[8] = {bf_lo(ga.x), bf_hi(ga.x), bf_lo(ga.y), bf_hi(ga.y), bf_lo(ga.z), bf_hi(ga.z), bf_lo(ga.w), bf_hi(ga.w)};
#endif
#pragma unroll
                        for (int j = 0; j < 4; ++j) { acc[ai][bj][m][0][j] *= sa[j] * __builtin_amdgcn_rcpf(fmaxf(sb[j], 1e-30f)); acc[ai][bj][m][1][j] *= sa[4 + j] * __builtin_amdgcn_rcpf(fmaxf(sb[4 + j], 1e-30f)); }
                    } else {
                        float v[8];
#pragma unroll
                        for (int j = 0; j < 4; ++j) { v[j] = acc[ai][bj][m][0][j] * sb[j]; v[4 + j] = acc[ai][bj][m][1][j] * sb[4 + j]; }
#if MK_FP8_PO
                        unsigned w0 = __builtin_amdgcn_cvt_pk_fp8_f32(v[0], v[1], 0u, false); w0 = __builtin_amdgcn_cvt_pk_fp8_f32(v[2], v[3], w0, true);
                        unsigned w1 = __builtin_amdgcn_cvt_pk_fp8_f32(v[4], v[5], 0u, false); w1 = __builtin_amdgcn_cvt_pk_fp8_f32(v[6], v[7], w1, true);
                        *(u32x2*)((unsigned char*)O + r * D + col0 + bj * 8) = (u32x2){w0, w1};
#else
                        u32x4 w; w.x = cvt_pk_bf16(v[0], v[1]); w.y = cvt_pk_bf16(v[2], v[3]); w.z = cvt_pk_bf16(v[4], v[5]); w.w = cvt_pk_bf16(v[6], v[7]);
                        *(u32x4*)(O + r * D + col0 + bj * 8) = w;
#endif
                    } } }
        return first;
    }
#endif
};
#ifndef MK_H1_BF16
#define MK_H1_BF16 0
#endif
struct EpiMix {
    struct Pre { template <int NAFTER> __device__ __forceinline__ void ready() {} }; __device__ __forceinline__ void preload(Pre&, const pg8::Unit&, int, int) const {}
#if MK_ROWS64
    ROWS_64
    static constexpr int BJS = 32, FQS = 8;
#else
    ROWS_GU
    static constexpr int BJS = 8, FQS = 16;
#endif
    static constexpr int VM_MIN = 16;
    bf16_t* out; const float* x;
#if MK_H1_BF16
    __device__ __forceinline__ void ldx(f32x4 (&xv)[2][2][2], int row0, int col0, int c) const {
#pragma unroll
        for (int mm = 0; mm < 2; ++mm) { const float* xp = x + (size_t)(row0 + (c >> 1) * 128 + (2 * (c & 1) + mm) * 16) * D + col0;
#pragma unroll
            for (int bj = 0; bj < 2; ++bj) { xv[mm][bj][0] = __builtin_nontemporal_load((const f32x4*)(xp + bj * BJS)); xv[mm][bj][1] = __builtin_nontemporal_load((const f32x4*)(xp + bj * BJS + 4)); } } }
#endif
    __device__ __forceinline__ void st(f32x4 (&acc)[2][2][4][2], f32x4 (&xv)[2][2][2], int row0, int col0, int c) const {
#pragma unroll
        for (int mm = 0; mm < 2; ++mm) { const int ai = c >> 1, m = 2 * (c & 1) + mm; bf16_t* rowp = out + (size_t)(row0 + ai * 128 + m * 16) * D + col0;
#pragma unroll
            for (int bj = 0; bj < 2; ++bj) { f32x4 v0 = acc[ai][bj][m][0], v1 = acc[ai][bj][m][1];
#if MK_H1_BF16
                v0 += xv[mm][bj][0]; v1 += xv[mm][bj][1];
#endif
                *(u32x4*)(rowp + bj * BJS) = (u32x4){cvt_pk_bf16(v0[0], v0[1]), cvt_pk_bf16(v0[2], v0[3]), cvt_pk_bf16(v1[0], v1[1]), cvt_pk_bf16(v1[2], v1[3])}; } } }
    __device__ __forceinline__ bool operator()(f32x4 (&acc)[2][2][4][2], const pg8::Unit& u, int wr, int wc, int fr, int fq, const Pre&) const {
        const int row0 = u.pm * 256 + wr * 64 + fr, col0 = u.pn * 256 + wc * 64 + FQS * fq;
        f32x4 xa[2][2][2], xb[2][2][2];
#if MK_H1_BF16
        ldx(xa, row0, col0, 0); ldx(xb, row0, col0, 1);
        st(acc, xa, row0, col0, 0); ldx(xa, row0, col0, 2);
        st(acc, xb, row0, col0, 1); ldx(xb, row0, col0, 3);
        st(acc, xa, row0, col0, 2); st(acc, xb, row0, col0, 3);
#else
#pragma unroll
        for (int c = 0; c < 4; ++c) st(acc, xa, row0, col0, c);
#endif
        return false;
    }
};
struct EpiGU {
    ROWS_GU
    static constexpr int VM_MIN = 8;
    bf16_t* act; const float* bias;
    struct Pre { f32x4 bv[2][2];
        template <int NAFTER> __device__ __forceinline__ void ready() { asm volatile("s_waitcnt vmcnt(%4)" : "+v"(bv[0][0]), "+v"(bv[0][1]), "+v"(bv[1][0]), "+v"(bv[1][1]) : "n"(NAFTER) : "memory"); } };
    __device__ __forceinline__ void preload(Pre& p, const pg8::Unit& u, int wc, int fq) const {
        const float* bp = bias + (size_t)u.aux * 4096 + u.pn * 256; const unsigned vo = (unsigned)(wc * 64 + 16 * fq) * 4u;
#pragma unroll
        for (int bj = 0; bj < 2; ++bj)
#pragma unroll
            for (int n = 0; n < 2; ++n) asm volatile("global_load_dwordx4 %0, %1, %2" : "=v"(p.bv[bj][n]) : "v"(vo + (unsigned)(8 * bj + 4 * n) * 4u), "s"(bp) : "memory"); }
    __device__ __forceinline__ bool operator()(f32x4 (&acc)[2][2][4][2], const pg8::Unit& u, int wr, int wc, int fr, int fq, const Pre& pre) const {
        const int row0 = u.r0 + wr * 64 + fr, col0 = u.pn * 256 + wc * 64 + 16 * fq;
        const f32x4 (&bv)[2][2] = pre.bv;
#pragma unroll
        for (int ai = 0; ai < 2; ++ai)
#pragma unroll
            for (int m = 0; m < 4; ++m) { float o[8];
#pragma unroll
                for (int bj = 0; bj < 2; ++bj)
#pragma unroll
                    for (int n = 0; n < 2; ++n) { const f32x4 v = acc[ai][bj][m][n] + bv[bj][n];
#if MK_PK_EPI
                        const f32x2 gate = {fminf(v[0], 7.f), fminf(v[2], 7.f)}, up = {fminf(fmaxf(v[1], -7.f), 7.f), fminf(fmaxf(v[3], -7.f), 7.f)};
                        const f32x2 r = (up + (f32x2){1.f, 1.f}) * (gate * sigm2k(gate, -1.702f * 1.4426950408889634f)); o[4 * bj + 2 * n] = r.x; o[4 * bj + 2 * n + 1] = r.y; }
#else
#pragma unroll
                        for (int p = 0; p < 2; ++p) { const float gate = fminf(v[2 * p], 7.f); const float up = fminf(fmaxf(v[2 * p + 1], -7.f), 7.f); o[4 * bj + 2 * n + p] = (up + 1.f) * (gate * fsigm(1.702f * gate)); } }
#endif
                const size_t r = (size_t)(row0 + ai * 128 + m * 16);
#if MK_FP8
                unsigned w0 = __builtin_amdgcn_cvt_pk_fp8_f32(o[0], o[1], 0u, false); w0 = __builtin_amdgcn_cvt_pk_fp8_f32(o[2], o[3], w0, true);
                unsigned w1 = __builtin_amdgcn_cvt_pk_fp8_f32(o[4], o[5], 0u, false); w1 = __builtin_amdgcn_cvt_pk_fp8_f32(o[6], o[7], w1, true);
                *(u32x2*)((unsigned char*)act + r * D + (col0 >> 1)) = (u32x2){w0, w1};
#else
                *(u32x4*)(act + r * D + (col0 >> 1)) = (u32x4){cvt_pk_bf16(o[0], o[1]), cvt_pk_bf16(o[2], o[3]), cvt_pk_bf16(o[4], o[5]), cvt_pk_bf16(o[6], o[7])};
#endif
            }
        return false;
    }
};
struct EpiDown {
    struct Pre { template <int NAFTER> __device__ __forceinline__ void ready() {} }; __device__ __forceinline__ void preload(Pre&, const pg8::Unit&, int, int) const {}
    ROWS_GU
    static constexpr int VM_MIN = MK_TAIL_SPLIT ? 4 : 8;
    unsigned char* yp; const float* bias; const float* roww;
    __device__ __forceinline__ bool operator()(f32x4 (&acc)[2][2][4][2], const pg8::Unit& u, int wr, int wc, int fr, int fq, const Pre&) const {
        const int ro = (MK_TAIL_SPLIT && u.half == 2) ? 128 : 0;
        const int rl0 = wr * 64 + fr + ro, col0 = u.pn * 256 + wc * 64 + 16 * fq; const float* bp = bias + (size_t)u.aux * D + col0; const float* wp = roww + (size_t)u.aux * NTOK + u.r0;
        f32x4 bv[2][2];
#pragma unroll
        for (int bj = 0; bj < 2; ++bj)
#pragma unroll
            for (int n = 0; n < 2; ++n) bv[bj][n] = *(const f32x4*)(bp + bj * 8 + 4 * n);
        float wv[2][4];
#pragma unroll
        for (int ai = 0; ai < 2; ++ai)
#pragma unroll
            for (int m = 0; m < 4; ++m) wv[ai][m] = wp[(rl0 + ai * 128 + m * 16) & 0xffffff];
        asm volatile("" ::: "memory");
#pragma unroll
        for (int ai = 0; ai < 2; ++ai) { if (MK_TAIL_SPLIT && ai == 1 && u.half != 0) break;
#pragma unroll
            for (int m = 0; m < 4; ++m) { const int rl = rl0 + ai * 128 + m * 16; const float w = wv[ai][m] * 16.f; unsigned o[4];
#pragma unroll
                for (int bj = 0; bj < 2; ++bj)
#pragma unroll
                    for (int n = 0; n < 2; ++n) { const f32x4 v = (acc[ai][bj][m][n] + bv[bj][n]) * w;
                        unsigned t = __builtin_amdgcn_cvt_pk_fp8_f32(v[0], v[1], 0u, false); o[2 * bj + n] = __builtin_amdgcn_cvt_pk_fp8_f32(v[2], v[3], t, true); }
                *(u32x4*)(yp + (size_t)(u.pm * 256 + rl) * D + col0) = (u32x4){o[0], o[1], o[2], o[3]}; } }
        return false;
    }
};

#ifndef MK_KF_PROBE
#define MK_KF_PROBE 0
#endif
template <int NCOL>
struct KFillW {
    static constexpr bool ON = true; static constexpr int NL = 4, NS = 4, NB = NCOL / 32, PER_E = 64 * NB, ITEMS = NE * PER_E;
    const float* W; unsigned char* WT; int nwv, gw, lane, fbase; unsigned ldsdead = 0;
    __device__ __forceinline__ void locate(int fi, size_t& src, size_t& dst) const {
        int it = (fbase + fi) * nwv + gw; it = it < ITEMS ? it : ITEMS - 1; if (MK_KF_PROBE == 1 || MK_KF_PROBE == 4 || MK_KF_PROBE == 6) it = gw;
        const int e = __builtin_amdgcn_readfirstlane(it / PER_E), q = __builtin_amdgcn_readfirstlane(it % PER_E), kb = q / NB, nb = q % NB;
        src = ((size_t)e * D * NCOL + (size_t)(kb * 32) * NCOL + (size_t)nb * 32) * 4; dst = (size_t)e * NCOL * D + (size_t)(nb * 32) * D + kb * 32; }
    __device__ __forceinline__ void issue(f32x4 (&kf)[4], int fi) const {
        size_t src, dst; locate(fi, src, dst); const char* ub = (const char*)W + src; const unsigned vo = (unsigned)((4 * (lane >> 3)) * NCOL + 4 * (lane & 7)) * 4u;
        if ((MK_KF_PROBE == 6 || MK_KF_PROBE == 7) && ldsdead != 0u) {
            const unsigned m0v = ldsdead; unsigned keep_;
#pragma unroll
            for (int i = 0; i < 4; ++i) asm volatile("s_mov_b32 %0, m0\n\ts_mov_b32 m0, %3\n\ts_nop 0\n\tglobal_load_lds_dwordx4 %1, %2\n\ts_mov_b32 m0, %0" : "=&s"(keep_) : "v"(vo), "s"(ub + (size_t)i * (NCOL * 4)), "s"(m0v) : "memory", "scc");
            return; }
#pragma unroll
        for (int i = 0; i < 4; ++i) asm volatile("global_load_dwordx4 %0, %1, %2 nt" : "=v"(kf[i]) : "v"(vo), "s"(ub + (size_t)i * (NCOL * 4)) : "memory"); }
    __device__ __forceinline__ void consume(f32x4 (&kf)[4], int fi) const {
        size_t src, dst; locate(fi, src, dst); unsigned char* ud = WT + dst; const unsigned vo = (unsigned)((4 * (lane & 7)) * D + 4 * (lane >> 3));
        if (MK_KF_PROBE == 3 || MK_KF_PROBE == 4 || MK_KF_PROBE == 6 || MK_KF_PROBE == 7) { asm volatile("" :: "v"(kf[0]), "v"(kf[1]), "v"(kf[2]), "v"(kf[3])); return; }
#pragma unroll
        for (int j = 0; j < 4; ++j) { const unsigned t = __builtin_amdgcn_cvt_pk_fp8_f32(kf[0][j] * 256.f, kf[1][j] * 256.f, 0u, false);
            *(unsigned*)(ud + vo + (size_t)j * D) = __builtin_amdgcn_cvt_pk_fp8_f32(kf[2][j] * 256.f, kf[3][j] * 256.f, t, true); } }
    __device__ __forceinline__ void finish(int fi, int fend = 1 << 30) const {
        for (; fi < fend && (fbase + fi) * nwv + gw < ITEMS; ++fi) { f32x4 kf[4]; issue(kf, fi); asm volatile("s_waitcnt vmcnt(0)" : "+v"(kf[0]), "+v"(kf[1]), "+v"(kf[2]), "+v"(kf[3]) :: "memory"); consume(kf, fi); } }
};
constexpr int KDN_P1 = 32;
#ifndef MK_DN_FILL
#define MK_DN_FILL (MK_GU_KFILL ? 0 : 1)
#endif
constexpr int DNF_NL = 8, DNF_KB = 8 * DNF_NL, DNF_ITEMS = NE * (D / DNF_KB) * 64;
#ifndef MK_DN_FILL_P7
#define MK_DN_FILL_P7 1
#endif
constexpr int DNF_UNITS = MK_DN_FILL_P7 ? 32 : 18;
struct DownFill {
    static constexpr bool ON = true; static constexpr int NL = DNF_NL, NS = 4;
    const float* W; unsigned char* WT; int ubase, nwv, gw, lane;
    __device__ __forceinline__ void locate(int ui, size_t& src, size_t& dst) const {
        int sl = ubase + ui; sl = sl < DNF_UNITS ? sl : DNF_UNITS - 1;
        int it = sl * nwv + gw; it = it < DNF_ITEMS ? it : DNF_ITEMS - 1;
        constexpr int PER_E = (D / DNF_KB) * 64; const int e = __builtin_amdgcn_readfirstlane(it / PER_E), q = __builtin_amdgcn_readfirstlane(it % PER_E), kb = q >> 6, nb = q & 63;
        src = ((size_t)e * D * D + (size_t)(kb * DNF_KB) * D + (size_t)nb * 32) * 4; dst = (size_t)e * D * D + (size_t)(nb * 32) * D + kb * DNF_KB; }
    template <int LO, int HI> __device__ __forceinline__ void issue_part(f32x4 (&ff)[DNF_NL], int ui) const {
        size_t src, dst; locate(ui, src, dst); const char* ub = (const char*)W + src; const unsigned vo = (unsigned)((DNF_NL * (lane >> 3)) * D + 4 * (lane & 7)) * 4u;
#pragma unroll
        for (int i = LO; i < HI; ++i) asm volatile("global_load_dwordx4 %0, %1, %2 nt" : "=v"(ff[i]) : "v"(vo + (unsigned)i * (D * 4u)), "s"(ub) : "memory"); }
    __device__ __forceinline__ void issue(f32x4 (&ff)[DNF_NL], int ui) const {
        size_t src, dst; locate(ui, src, dst); const char* ub = (const char*)W + src; const unsigned vo = (unsigned)((DNF_NL * (lane >> 3)) * D + 4 * (lane & 7)) * 4u;
#if MK_FILL_ASM
#pragma unroll
        for (int i = 0; i < DNF_NL; ++i) asm volatile("global_load_dwordx4 %0, %1, %2 nt" : "=v"(ff[i]) : "v"(vo + (unsigned)i * (D * 4u)), "s"(ub) : "memory");
#else
#pragma unroll
        for (int i = 0; i < DNF_NL; ++i) ff[i] = __builtin_nontemporal_load((const f32x4*)(ub + (size_t)i * (D * 4) + vo));
        asm volatile("" ::: "memory");
#endif
    }
    template <int NAFTER> __device__ __forceinline__ void consume_w(f32x4 (&ff)[DNF_NL], int ui) const {
        static_assert(DNF_NL == 8, "tie");
        asm volatile("s_waitcnt vmcnt(%8)" : "+v"(ff[0]), "+v"(ff[1]), "+v"(ff[2]), "+v"(ff[3]), "+v"(ff[4]), "+v"(ff[5]), "+v"(ff[6]), "+v"(ff[7]) : "n"(NAFTER) : "memory");
        consume(ff, ui); }
    __device__ __forceinline__ void consume(f32x4 (&ff)[DNF_NL], int ui) const {
        size_t src, dst; locate(ui, src, dst); unsigned char* ud = WT + dst; const unsigned vo = (unsigned)((4 * (lane & 7)) * D + DNF_NL * (lane >> 3));
#pragma unroll
        for (int j = 0; j < 4; ++j) { unsigned w[DNF_NL / 4];
#pragma unroll
            for (int d = 0; d < DNF_NL / 4; ++d) { const unsigned t = __builtin_amdgcn_cvt_pk_fp8_f32(ff[4 * d][j] * 256.f, ff[4 * d + 1][j] * 256.f, 0u, false); w[d] = __builtin_amdgcn_cvt_pk_fp8_f32(ff[4 * d + 2][j] * 256.f, ff[4 * d + 3][j] * 256.f, t, true); }
            if constexpr (DNF_NL == 16) *(u32x4*)(ud + vo + (size_t)j * D) = (u32x4){w[0], w[1], w[2], w[3]}; else *(u32x2*)(ud + vo + (size_t)j * D) = (u32x2){w[0], w[1]}; } }
};

#define LDS_WAIT() asm volatile("s_waitcnt lgkmcnt(0)" ::: "memory")
#define VM_WAIT() asm volatile("s_waitcnt vmcnt(0)" ::: "memory")

__device__ __forceinline__ void p0_transpose_item(const float* W, size_t ldw, bf16_t* WT, size_t ldt, int k0, int n0s, int n0d, LAS float* scr, int lane) {
#pragma unroll 8
    for (int i = 0; i < 32; ++i) { const int kk = 2 * i + (lane >> 5); scr[kk * 33 + (lane & 31)] = __builtin_nontemporal_load(W + (size_t)(k0 + kk) * ldw + n0s + (lane & 31)); }
    LDS_WAIT(); asm volatile("" ::: "memory");
    const int c = lane & 7;
#pragma unroll
    for (int j = 0; j < 4; ++j) { const int n = (lane >> 3) + 8 * j; const LAS float* s = scr + (8 * c) * 33 + n;
        u32x4 o; o.x = pk2(s[0 * 33], s[1 * 33]); o.y = pk2(s[2 * 33], s[3 * 33]); o.z = pk2(s[4 * 33], s[5 * 33]); o.w = pk2(s[6 * 33], s[7 * 33]);
        *(u32x4*)(WT + (size_t)(n0d + n) * ldt + k0 + 8 * c) = o; }
    LDS_WAIT(); asm volatile("" ::: "memory");
}
__device__ __forceinline__ void p0_transpose_item_f8(const float* W, size_t ldw, unsigned char* WT, size_t ldt, int k0, int n0s, int n0d, LAS float* scr, int lane) {
#pragma unroll 8
    for (int i = 0; i < 32; ++i) { const int kk = 2 * i + (lane >> 5); scr[kk * 33 + (lane & 31)] = __builtin_nontemporal_load(W + (size_t)(k0 + kk) * ldw + n0s + (lane & 31)); }
    LDS_WAIT(); asm volatile("" ::: "memory");
    const int c = lane & 7;
#pragma unroll
    for (int j = 0; j < 4; ++j) { const int n = (lane >> 3) + 8 * j; const LAS float* s = scr + (8 * c) * 33 + n;
        unsigned w0 = __builtin_amdgcn_cvt_pk_fp8_f32(s[0 * 33] * 256.f, s[1 * 33] * 256.f, 0u, false); w0 = __builtin_amdgcn_cvt_pk_fp8_f32(s[2 * 33] * 256.f, s[3 * 33] * 256.f, w0, true);
        unsigned w1 = __builtin_amdgcn_cvt_pk_fp8_f32(s[4 * 33] * 256.f, s[5 * 33] * 256.f, 0u, false); w1 = __builtin_amdgcn_cvt_pk_fp8_f32(s[6 * 33] * 256.f, s[7 * 33] * 256.f, w1, true);
        *(u32x2*)(WT + (size_t)(n0d + n) * ldt + k0 + 8 * c) = (u32x2){w0, w1}; }
    LDS_WAIT(); asm volatile("" ::: "memory");
}
__device__ __forceinline__ void p0_transpose_item_f8w(const float* W, size_t ldw, unsigned char* WT, size_t ldt, int k0, int n0, LAS float* scr, int lane) {
#pragma unroll 8
    for (int i = 0; i < 32; ++i) scr[i * 65 + lane] = __builtin_nontemporal_load(W + (size_t)(k0 + i) * ldw + n0 + lane);
    LDS_WAIT(); asm volatile("" ::: "memory");
    const int c = lane & 3;
#pragma unroll
    for (int j = 0; j < 4; ++j) { const int n = (lane >> 2) + 16 * j; const LAS float* s = scr + (8 * c) * 65 + n;
        unsigned w0 = __builtin_amdgcn_cvt_pk_fp8_f32(s[0 * 65] * 256.f, s[1 * 65] * 256.f, 0u, false); w0 = __builtin_amdgcn_cvt_pk_fp8_f32(s[2 * 65] * 256.f, s[3 * 65] * 256.f, w0, true);
        unsigned w1 = __builtin_amdgcn_cvt_pk_fp8_f32(s[4 * 65] * 256.f, s[5 * 65] * 256.f, 0u, false); w1 = __builtin_amdgcn_cvt_pk_fp8_f32(s[6 * 65] * 256.f, s[7 * 65] * 256.f, w1, true);
        *(u32x2*)(WT + (size_t)(n0 + n) * ldt + k0 + 8 * c) = (u32x2){w0, w1}; }
    LDS_WAIT(); asm volatile("" ::: "memory");
}
__device__ __forceinline__ void rms_row_to_bf16(const float* xrow, const float* g, bf16_t* orow, unsigned* orow8, int lane) {
    const f32x4* xr = (const f32x4*)xrow + lane; const f32x4* gr = (const f32x4*)g + lane;
    f32x4 v[8]; float s = 0.f;
#pragma unroll
    for (int j = 0; j < 8; ++j) { v[j] = __builtin_nontemporal_load(xr + 64 * j); s += (v[j].x * v[j].x + v[j].y * v[j].y) + (v[j].z * v[j].z + v[j].w * v[j].w); }
    const float r = rsqrtf(wave_sum(s) * (1.f / D) + RMS_EPS);
    u32x2* o8 = (u32x2*)orow + lane;
#pragma unroll
    for (int j = 0; j < 8; ++j) { const f32x4 gg = gr[64 * j]; const f32x4 y = {v[j].x * r * gg.x, v[j].y * r * gg.y, v[j].z * r * gg.z, v[j].w * r * gg.w};
        u32x2 w; w.x = pk2(y.x, y.y); w.y = pk2(y.z, y.w); o8[64 * j] = w;
#if MK_FP8_MG
        unsigned w8 = __builtin_amdgcn_cvt_pk_fp8_f32(y.x, y.y, 0u, false); w8 = __builtin_amdgcn_cvt_pk_fp8_f32(y.z, y.w, w8, true); orow8[lane + 64 * j] = w8;
#endif
    }
}
#ifndef MK_P0_LRSPLIT
#define MK_P0_LRSPLIT 1
#endif
__device__ __forceinline__ void p0_prologue(Frame& F) {
    LAS float* scr = (LAS float*)(F.lds + F.wave * 16384);
    const int gw = F.vcu * NWAVES + F.wave, NGW = F.G * NWAVES;
    { const int gt = gw * 64 + F.lane, NGT = NGW * 64;
      for (int i = gt; i < 2048; i += NGT) { const int d = i >> 10, c = i & 1023; const float a = F.lb_logits[(d * 2 + 0) * 1024 + c], b = F.lb_logits[(d * 2 + 1) * 1024 + c];
          const float m = fmaxf(a, b), ea = __expf(a - m), eb = __expf(b - m); WSP(float, WS_LB)[i] = ea / (ea + eb); }
      for (int i = gt; i < 2 * 512 * 32; i += NGT) { const int r = i & 31, c = (i >> 5) & 511, d = i >> 14; WSP(bf16_t, WS_W2T)[i] = r < 16 ? (bf16_t)f2bf(F.gla_w2[(d * 16 + r) * 512 + c]) : (bf16_t)0; } }
#if MK_P0_LRSPLIT
    for (int k = gw; k < D; k += NGW) if (F.lane < 32) WSP(bf16_t, WS_WLRT)[(size_t)F.lane * D + k] = (bf16_t)f2bf(F.w_in[(size_t)k * DIN + 8192 + F.lane]);
#endif
    for (int m = gw; m < NTOK; m += NGW) rms_row_to_bf16(F.x + (size_t)m * D, F.norm1_g, WSP(bf16_t, WS_XN) + (size_t)m * D, (unsigned*)(F.ws + WS_XN8 + (size_t)m * D), F.lane);
    constexpr int I_IN = 32 * (MK_P0_LRSPLIT ? 384 : 385), I_PA = 16 * 64, I_OUT = 32 * 64, I_GU = (MK_FP8 && MK_GU_KFILL && !MK_KF_PROBE) ? 0 : (MK_FP8 && MK_GU_IN_P2 && !MK_GU_PROBE) ? MK_GU_P2_SKIP * 2048 : (MK_FP8 ? 16 : 32) * 32 * 128, I_DN = (MK_FP8 && (MK_DN_FILL || (MK_GU_KFILL && !MK_KF_PROBE))) ? 0 : (MK_FP8 ? 16 : 32) * 32 * 64;
    constexpr int DN_FIRST = DNF_UNITS * 256 * NWAVES;
    constexpr int NITEMS = I_IN + 2 * I_PA + I_OUT + I_GU + I_DN;
    for (int it = gw; it < NITEMS; it += NGW) {
        int r = it;
#if MK_P0_LRSPLIT
        if (r < I_IN) { const int kb = r / 384, nbq = r % 384, nb = nbq < 256 ? nbq : nbq + 1;
#else
        if (r < I_IN) { const int kb = r / 385, nb = r % 385;
#endif
#if MK_FP8_MG && MK_FP8_VG
            if (nb == 256) p0_transpose_item(F.w_in, DIN, WSP(bf16_t, WS_WLRT), D, kb * 64, nb * 32, 0, scr, F.lane);
            else { const int zc = (nb < 256 ? nb : nb - 1) * 32;
                if (in_tile_is_f8(zc >> 8)) p0_transpose_item_f8(F.w_in, DIN, WSP(unsigned char, WS_WINT8), D, kb * 64, nb * 32, zc, scr, F.lane);
                else p0_transpose_item(F.w_in, DIN, WSP(bf16_t, WS_WINT), D, kb * 64, nb * 32, zc, scr, F.lane); }
#elif MK_FP8_MG
            if (nb < 256) p0_transpose_item(F.w_in, DIN, WSP(bf16_t, WS_WINT), D, kb * 64, nb * 32, nb * 32, scr, F.lane);
            else if (nb == 256) p0_transpose_item(F.w_in, DIN, WSP(bf16_t, WS_WLRT), D, kb * 64, nb * 32, 0, scr, F.lane);
            else p0_transpose_item_f8(F.w_in, DIN, WSP(unsigned char, WS_WINT8), D, kb * 64, nb * 32, (nb - 257) * 32, scr, F.lane);
#else
            if (nb < 256) p0_transpose_item(F.w_in, DIN, WSP(bf16_t, WS_WINT), D, kb * 64, nb * 32, nb * 32, scr, F.lane);
            else if (nb == 256) p0_transpose_item(F.w_in, DIN, WSP(bf16_t, WS_WLRT), D, kb * 64, nb * 32, 0, scr, F.lane);
            else p0_transpose_item(F.w_in, DIN, WSP(bf16_t, WS_WINT), D, kb * 64, nb * 32, (nb - 1) * 32, scr, F.lane);
#endif
            continue; } r -= I_IN;
#if MK_FP8_PO
        if (r < I_PA) { p0_transpose_item_f8(F.w_proj_a, D, WSP(unsigned char, WS_WPAT), 1024, (r / 64) * 64, (r % 64) * 32, (r % 64) * 32, scr, F.lane); continue; } r -= I_PA;
        if (r < I_PA) { p0_transpose_item_f8(F.w_proj_b, D, WSP(unsigned char, WS_WPBT), 1024, (r / 64) * 64, (r % 64) * 32, (r % 64) * 32, scr, F.lane); continue; } r -= I_PA;
        if (r < I_OUT) { p0_transpose_item_f8(F.w_out, D, WSP(unsigned char, WS_WOUTT), D, (r / 64) * 64, (r % 64) * 32, (r % 64) * 32, scr, F.lane); continue; } r -= I_OUT;
#else
        if (r < I_PA) { p0_transpose_item(F.w_proj_a, D, WSP(bf16_t, WS_WPAT), 1024, (r / 64) * 64, (r % 64) * 32, (r % 64) * 32, scr, F.lane); continue; } r -= I_PA;
        if (r < I_PA) { p0_transpose_item(F.w_proj_b, D, WSP(bf16_t, WS_WPBT), 1024, (r / 64) * 64, (r % 64) * 32, (r % 64) * 32, scr, F.lane); continue; } r -= I_PA;
        if (r < I_OUT) { p0_transpose_item(F.w_out, D, WSP(bf16_t, WS_WOUTT), D, (r / 64) * 64, (r % 64) * 32, (r % 64) * 32, scr, F.lane); continue; } r -= I_OUT;
#endif
#if MK_FP8
        if (r < I_GU) { const int rr = (MK_FP8 && MK_GU_IN_P2 && !MK_GU_PROBE) ? r + (32 - MK_GU_P2_SKIP) * 2048 : r; const int e = rr / 2048, q = rr % 2048, k0 = (q / 128) * 128, n0 = (q % 128) * 32; const float* Ws = F.w_gate_up + (size_t)e * D * 4096; unsigned char* Wd = WSP(unsigned char, WS_WGUT) + (size_t)e * 4096 * D;
            p0_transpose_item_f8(Ws, 4096, Wd, D, k0, n0, n0, scr, F.lane); p0_transpose_item_f8(Ws, 4096, Wd, D, k0 + 64, n0, n0, scr, F.lane); continue; } r -= I_GU;
        { const int e = r / 1024, q = r % 1024, k0 = (q / 64) * 128, n0 = (q % 64) * 32; const float* Ws = F.w_down + (size_t)e * D * D; unsigned char* Wd = WSP(unsigned char, WS_WDNT) + (size_t)e * D * D;
            p0_transpose_item_f8(Ws, D, Wd, D, k0, n0, n0, scr, F.lane); p0_transpose_item_f8(Ws, D, Wd, D, k0 + 64, n0, n0, scr, F.lane); }
#else
        if (r < I_GU) { const int e = r / 4096, q = r % 4096; p0_transpose_item(F.w_gate_up + (size_t)e * D * 4096, 4096, WSP(bf16_t, WS_WGUT) + (size_t)e * 4096 * D, D, (q / 128) * 64, (q % 128) * 32, (q % 128) * 32, scr, F.lane); continue; } r -= I_GU;
        { const int e = r / 2048, q = r % 2048; p0_transpose_item(F.w_down + (size_t)e * D * D, D, WSP(bf16_t, WS_WDNT) + (size_t)e * D * D, D, (q / 64) * 64, (q % 64) * 32, (q % 64) * 32, scr, F.lane); }
#endif
    }
#if MK_FP8 && MK_DN_FILL
    for (int it = DN_FIRST + gw; it < DNF_ITEMS; it += NGW) { const int e = it >> 11, q = it & 2047, kb = q >> 6, nb = q & 63;
        p0_transpose_item_f8(F.w_down + (size_t)e * D * D, D, WSP(unsigned char, WS_WDNT) + (size_t)e * D * D, D, kb * 64, nb * 32, nb * 32, scr, F.lane); }
#endif
}

__device__ __forceinline__ void p1_gates(Frame& F, int gi, int GG_) {
    const int blk = F.wave * GG_ + gi;
    LAS bf16_t* lrs = (LAS bf16_t*)(F.lds + F.wave * 2048);
    if (blk < NTOK / 16) {
        const int tok0 = blk * 16, fr = F.lane & 15, fq = F.lane >> 4;
        const bf16_t* xa = WSP(bf16_t, WS_XN) + (size_t)(tok0 + fr) * D + fq * 8;
        const bf16_t* wl0 = WSP(bf16_t, WS_WLRT) + (size_t)fr * D + fq * 8; const bf16_t* wl1 = wl0 + (size_t)16 * D;
        f32x4 a0 = {0.f, 0.f, 0.f, 0.f}, a1 = {0.f, 0.f, 0.f, 0.f};
#pragma unroll 4
        for (int ks = 0; ks < 64; ++ks) { const bf16x8 a = *(const bf16x8*)(xa + ks * 32), b0 = *(const bf16x8*)(wl0 + ks * 32), b1 = *(const bf16x8*)(wl1 + ks * 32);
            a0 = __builtin_amdgcn_mfma_f32_16x16x32_bf16(a, b0, a0, 0, 0, 0); a1 = __builtin_amdgcn_mfma_f32_16x16x32_bf16(a, b1, a1, 0, 0, 0); }
#pragma unroll
        for (int i = 0; i < 4; ++i) { lrs[(0 * 16 + 4 * fq + i) * 32 + fr] = (bf16_t)f2bf(a0[i]); lrs[(1 * 16 + 4 * fq + i) * 32 + fr] = (bf16_t)f2bf(a1[i]); lrs[(0 * 16 + 4 * fq + i) * 32 + 16 + fr] = 0; lrs[(1 * 16 + 4 * fq + i) * 32 + 16 + fr] = 0; }
        LDS_WAIT(); asm volatile("" ::: "memory");
#pragma unroll
        for (int d = 0; d < 2; ++d) {
            const bf16x8 lrf = *(const LAS bf16x8*)(lrs + (d * 16 + fr) * 32 + fq * 8);
            const bf16_t* w2p = WSP(bf16_t, WS_W2T) + ((size_t)d * 512 + fr) * 32 + fq * 8;
            const float* bp = F.gla_b + d * 512 + 4 * fq;
            bf16_t* gout = WSP(bf16_t, WS_GGLA) + (size_t)(tok0 + fr) * 1024 + d * 512 + 4 * fq;
#pragma unroll 4
            for (int ct = 0; ct < 32; ++ct) {
                const bf16x8 wa = *(const bf16x8*)(w2p + (size_t)ct * 16 * 32);
                f32x4 lg = __builtin_amdgcn_mfma_f32_16x16x32_bf16(wa, lrf, (f32x4){0.f, 0.f, 0.f, 0.f}, 0, 0, 0);
                const f32x4 bb = *(const f32x4*)(bp + ct * 16); float g[4];
#pragma unroll
                for (int i = 0; i < 4; ++i) { const float x = lg[i] + bb[i]; g[i] = (fminf(x, 0.f) - __logf(1.f + __expf(-fabsf(x)))) * (1.f / 16.f); }
                u32x2 w; w.x = cvt_pk_bf16(g[0], g[1]); w.y = cvt_pk_bf16(g[2], g[3]);
                *(u32x2*)(gout + ct * 16) = w;
            }
        }
    }
    VM_WAIT(); __syncthreads();
}

constexpr int RQ_PQ = 272, RQ_PT = 144;
constexpr int RL_QS = 0, RL_KS = 17408, RL_KT = 34816, RL_VT = 53248, RL_ST = 71680, RL_VEC = 106496;
static_assert(RL_VEC + 1536 <= RING_BYTES, "recurrence LDS map");
__device__ __forceinline__ float scan64(float v) {
    int t;
    t = __builtin_amdgcn_update_dpp(0, __builtin_bit_cast(int, v), 0x111, 0xf, 0xf, true); v += __builtin_bit_cast(float, t);
    t = __builtin_amdgcn_update_dpp(0, __builtin_bit_cast(int, v), 0x112, 0xf, 0xf, true); v += __builtin_bit_cast(float, t);
    t = __builtin_amdgcn_update_dpp(0, __builtin_bit_cast(int, v), 0x114, 0xf, 0xf, true); v += __builtin_bit_cast(float, t);
    t = __builtin_amdgcn_update_dpp(0, __builtin_bit_cast(int, v), 0x118, 0xf, 0xf, true); v += __builtin_bit_cast(float, t);
    t = __builtin_amdgcn_update_dpp(0, __builtin_bit_cast(int, v), 0x142, 0xa, 0xf, false); v += __builtin_bit_cast(float, t);
    t = __builtin_amdgcn_update_dpp(0, __builtin_bit_cast(int, v), 0x143, 0xc, 0xf, false); v += __builtin_bit_cast(float, t);
    return v;
}
#define RECUR_ISSUE(n_) do { const int cidx_ = dir ? 31 - (n_) : (n_); const size_t tq_ = (size_t)(b * TSEQ + cidx_ * 64 + (dir ? 63 - lane : lane)); \
            const u32x4* qp_ = (const u32x4*)(Z + tq_ * NZ + qcol); pq[0] = qp_[0]; pq[1] = qp_[1]; \
            const u32x4* gp_ = (const u32x4*)(gbase + tq_ * gpitch); pg[0] = gp_[0]; pg[1] = gp_[1]; \
            { const u32x4* kp_ = gla ? (const u32x4*)(Z + tq_ * NZ + kcol) : gp_; pk[0] = kp_[0]; pk[1] = kp_[1]; } \
            const u32x4* vp_ = (const u32x4*)(Z + tq_ * NZ + vcol); pv[0] = vp_[0]; pv[1] = vp_[1]; } while (0)
constexpr int GU_ITEMS = 32 * 16 * 128;
#define GU_FILL_ISSUE(it_) do { { const int itc_ = (it_) < GU_ITEMS ? (it_) : GU_ITEMS - 1; const int e_ = __builtin_amdgcn_readfirstlane(itc_ >> 11), q_ = __builtin_amdgcn_readfirstlane(itc_ & 2047); \
        const char* ub_ = (const char*)F.w_gate_up + ((size_t)e_ * D * 4096 + (size_t)((q_ >> 7) * 128) * 4096 + (size_t)(q_ & 127) * 32) * 4; \
        _Pragma("unroll") for (int i_ = 0; i_ < 16; ++i_) fv[i_] = __builtin_nontemporal_load((const f32x4*)(ub_ + (size_t)i_ * 16384 + fvoff_ld)); } asm volatile("" ::: "memory"); } while (0)
#define GU_FILL_ISSUE_PART(it_, i0_, i1_) do { { const int itc_ = (it_) < GU_ITEMS ? (it_) : GU_ITEMS - 1; const int e_ = __builtin_amdgcn_readfirstlane(itc_ >> 11), q_ = __builtin_amdgcn_readfirstlane(itc_ & 2047); \
        const char* ub_ = (const char*)F.w_gate_up + ((size_t)e_ * D * 4096 + (size_t)((q_ >> 7) * 128) * 4096 + (size_t)(q_ & 127) * 32) * 4; \
        _Pragma("unroll") for (int i_ = (i0_); i_ < (i1_); ++i_) fv[i_] = __builtin_nontemporal_load((const f32x4*)(ub_ + (size_t)i_ * 16384 + fvoff_ld)); } asm volatile("" ::: "memory"); } while (0)
#define GU_FILL_STORE(it_) do { { const int itc_ = (it_) < GU_ITEMS ? (it_) : GU_ITEMS - 1; const int e_ = __builtin_amdgcn_readfirstlane(itc_ >> 11), q_ = __builtin_amdgcn_readfirstlane(itc_ & 2047); \
        unsigned char* ud_ = WSP(unsigned char, MK_GU_PROBE ? WS_ACT : WS_WGUT) + (size_t)e_ * 4096 * D + (size_t)((q_ & 127) * 32) * D + (q_ >> 7) * 128; \
        if (MK_GU_PROBE == 2) { _Pragma("unroll") for (int i_ = 0; i_ < 16; ++i_) asm volatile("" :: "v"(fv[i_])); } else \
        _Pragma("unroll") for (int j_ = 0; j_ < 4; ++j_) { unsigned w_[4]; \
            _Pragma("unroll") for (int d_ = 0; d_ < 4; ++d_) { const unsigned t_ = __builtin_amdgcn_cvt_pk_fp8_f32(fv[4 * d_][j_] * 256.f, fv[4 * d_ + 1][j_] * 256.f, 0u, false); w_[d_] = __builtin_amdgcn_cvt_pk_fp8_f32(fv[4 * d_ + 2][j_] * 256.f, fv[4 * d_ + 3][j_] * 256.f, t_, true); } \
            *(u32x4*)(ud_ + fvoff_st + (size_t)j_ * D) = (u32x4){w_[0], w_[1], w_[2], w_[3]}; } } } while (0)
__device__ __forceinline__ void recur_item(Frame& F, int item) {
    LAS unsigned char* L = F.lds;
    const int lane = F.lane, w = F.wave, fr = lane & 15, fq = lane >> 4;
    const bool gla = item >= 128; const int j_ = item & 127;
    const int b = j_ >> 4, dir = j_ & 1, h = gla ? (j_ >> 2) & 3 : (j_ >> 1) & 7, half = (j_ >> 1) & 1;
    const bf16_t* Z = WSP(bf16_t, WS_ZB); bf16_t* OB = WSP(bf16_t, dir ? WS_OBUF2 : WS_OBUF);
    const int qcol = (gla ? Z_GQ : Z_HQ) + h * 128 + 16 * w, kcol = Z_GK + h * 128 + 16 * w;
    const int vcol = (gla ? Z_GV + h * 256 + half * 128 : Z_HI + h * 128) + 16 * w;
    const int ocol = gla ? 1024 + h * 256 + half * 128 : h * 128;
    const bf16_t* gbase = gla ? WSP(bf16_t, WS_GGLA) + dir * 512 + h * 128 + 16 * w : Z + (dir ? Z_HFB : Z_HFF) + h * 128 + 16 * w; const size_t gpitch = gla ? 1024 : NZ;
    const int tr = w >> 1, h2 = w & 1;
    f32x4 st[8];
#pragma unroll
    for (int vt = 0; vt < 8; ++vt) st[vt] = (f32x4){0.f, 0.f, 0.f, 0.f};
    u32x4 pq[2], pk[2], pg[2], pv[2];
    pk[0] = (u32x4){0u, 0u, 0u, 0u}; pk[1] = pk[0];
    RECUR_ISSUE(0);
#if MK_FP8 && MK_GU_IN_P2
    const unsigned fvoff_ld = (unsigned)((16 * (lane >> 3)) * 4096 + 4 * (lane & 7)) * 4u, fvoff_st = (unsigned)((4 * (lane & 7)) * D + 16 * (lane >> 3));
    f32x4 fv[16]; const int fgw = F.vcu * NWAVES + w, FNGW = F.G * NWAVES;
#endif
#pragma unroll 1
    for (int n = 0; n < 32; ++n) {
        const int cidx = dir ? 31 - n : n;
        float q[16], kk[16], bb[16];
        {
            const unsigned qa[8] = {pq[0].x, pq[0].y, pq[0].z, pq[0].w, pq[1].x, pq[1].y, pq[1].z, pq[1].w};
            const unsigned ka[8] = {pk[0].x, pk[0].y, pk[0].z, pk[0].w, pk[1].x, pk[1].y, pk[1].z, pk[1].w};
            const unsigned ga[8] = {pg[0].x, pg[0].y, pg[0].z, pg[0].w, pg[1].x, pg[1].y, pg[1].z, pg[1].w};
#pragma unroll
            for (int j = 0; j < 8; ++j) { q[2 * j] = bf_lo(qa[j]); q[2 * j + 1] = bf_hi(qa[j]); kk[2 * j] = bf_lo(ka[j]); kk[2 * j + 1] = bf_hi(ka[j]); bb[2 * j] = bf_lo(ga[j]); bb[2 * j + 1] = bf_hi(ga[j]); }
        }
        if (!gla) {
#pragma unroll
            for (int j = 0; j < 16; ++j) kk[j] = 1.f - __expf(bb[j]);
        }
        const u32x4 va0 = pv[0], va1 = pv[1];
#pragma unroll
        for (int j = 0; j < 16; ++j) bb[j] = scan64(bb[j]);
        float myr = 0.f, mybl = 0.f;
        unsigned qw[8], kw[8]; unsigned short kt16[16];
#pragma unroll
        for (int j = 0; j < 16; ++j) {
            const float r = __builtin_bit_cast(float, __builtin_amdgcn_readlane(__builtin_bit_cast(int, bb[j]), 31));
            const float bl = __builtin_bit_cast(float, __builtin_amdgcn_readlane(__builtin_bit_cast(int, bb[j]), 63));
            if (lane == j) { myr = r; mybl = bl; }
            const float dlt = fminf(fmaxf(bb[j] - r, -60.f), 60.f);
            const float eq = __expf(dlt), ek = __builtin_amdgcn_rcpf(eq);
            q[j] *= eq; kk[j] *= ek;
        }
#pragma unroll
        for (int j = 0; j < 8; ++j) { qw[j] = pk2(q[2 * j], q[2 * j + 1]); kw[j] = pk2(kk[2 * j], kk[2 * j + 1]); kt16[2 * j] = (unsigned short)(kw[j] & 0xffffu); kt16[2 * j + 1] = (unsigned short)(kw[j] >> 16); }
        const float e_r = __expf(fmaxf(myr, -80.f)), e_l = __expf(fmaxf(mybl, -80.f)), e_d = __expf(fmaxf(mybl - myr, -80.f));
#if MK_FP8 && MK_GU_IN_P2
        if (n > 0) GU_FILL_STORE(((n - 1 > MK_GU_P2_SKIP ? n - 1 : MK_GU_P2_SKIP) - MK_GU_P2_SKIP) * FNGW + fgw);
#endif
        __syncthreads();
#pragma unroll
        for (int j = 0; j < 16; ++j) *(LAS bf16_t*)(L + RL_KT + (16 * w + j) * RQ_PT + lane * 2) = kt16[j];
        *(LAS u32x4*)(L + RL_QS + lane * RQ_PQ + 32 * w) = (u32x4){qw[0], qw[1], qw[2], qw[3]}; *(LAS u32x4*)(L + RL_QS + lane * RQ_PQ + 32 * w + 16) = (u32x4){qw[4], qw[5], qw[6], qw[7]};
        *(LAS u32x4*)(L + RL_KS + lane * RQ_PQ + 32 * w) = (u32x4){kw[0], kw[1], kw[2], kw[3]}; *(LAS u32x4*)(L + RL_KS + lane * RQ_PQ + 32 * w + 16) = (u32x4){kw[4], kw[5], kw[6], kw[7]};
        { const unsigned vw[8] = {va0.x, va0.y, va0.z, va0.w, va1.x, va1.y, va1.z, va1.w};
#pragma unroll
          for (int j = 0; j < 8; ++j) { *(LAS bf16_t*)(L + RL_VT + (16 * w + 2 * j) * RQ_PT + lane * 2) = (bf16_t)(vw[j] & 0xffffu); *(LAS bf16_t*)(L + RL_VT + (16 * w + 2 * j + 1) * RQ_PT + lane * 2) = (bf16_t)(vw[j] >> 16); } }
        if (lane < 16) { LAS float* vec = (LAS float*)(L + RL_VEC); vec[16 * w + lane] = e_r; vec[128 + 16 * w + lane] = e_l; vec[256 + 16 * w + lane] = e_d; }
        RECUR_ISSUE(n + 1 < 32 ? n + 1 : 31);
        LDS_WAIT();
        const f32x4 er = *(const LAS f32x4*)(L + RL_VEC + (16 * w + 4 * fq) * 4), dl = *(const LAS f32x4*)(L + RL_VEC + (128 + 16 * w + 4 * fq) * 4), dr = *(const LAS f32x4*)(L + RL_VEC + (256 + 16 * w + 4 * fq) * 4);
#pragma unroll
        for (int vt = 0; vt < 8; ++vt) { u32x2 sw; sw.x = pk2(st[vt][0] * er[0], st[vt][1] * er[1]); sw.y = pk2(st[vt][2] * er[2], st[vt][3] * er[3]);
            *(LAS u32x2*)(L + RL_ST + (16 * vt + fr) * RQ_PQ + (16 * w + 4 * fq) * 2) = sw; }
        LDS_WAIT(); __syncthreads();
#if MK_FP8 && MK_GU_IN_P2
        GU_FILL_ISSUE_PART(((n > MK_GU_P2_SKIP ? n : MK_GU_P2_SKIP) - MK_GU_P2_SKIP) * FNGW + fgw, 0, MK_GU_SPLIT);
#endif
        bf16x8 bqf[4];
#pragma unroll
        for (int ks = 0; ks < 4; ++ks) bqf[ks] = *(const LAS bf16x8*)(L + RL_QS + (16 * tr + fr) * RQ_PQ + ks * 64 + fq * 16);
        f32x4 sc[4];
#pragma unroll
        for (int tc = 0; tc < 4; ++tc) { sc[tc] = (f32x4){0.f, 0.f, 0.f, 0.f};
            if (tc <= tr) {
#pragma unroll
                for (int ks = 0; ks < 4; ++ks) { const bf16x8 a = *(const LAS bf16x8*)(L + RL_KS + (16 * tc + fr) * RQ_PQ + ks * 64 + fq * 16);
                    sc[tc] = __builtin_amdgcn_mfma_f32_16x16x32_bf16(a, bqf[ks], sc[tc], 0, 0, 0); }
                if (tc == tr) {
#pragma unroll
                    for (int i = 0; i < 4; ++i) if (4 * fq + i > fr) sc[tc][i] = 0.f;
                }
            } }
        bf16x8 pf[2];
#pragma unroll
        for (int ks = 0; ks < 2; ++ks) { const u32x4 t4 = {pk2(sc[2 * ks][0], sc[2 * ks][1]), pk2(sc[2 * ks][2], sc[2 * ks][3]), pk2(sc[2 * ks + 1][0], sc[2 * ks + 1][1]), pk2(sc[2 * ks + 1][2], sc[2 * ks + 1][3])}; pf[ks] = __builtin_bit_cast(bf16x8, t4); }
        const size_t trow = (size_t)(b * TSEQ + cidx * 64 + (dir ? 63 - (16 * tr + fr) : (16 * tr + fr)));
#pragma unroll
        for (int vv = 0; vv < 4; ++vv) { const int vt = 4 * h2 + vv;
            f32x4 o = {0.f, 0.f, 0.f, 0.f};
#pragma unroll
            for (int ks = 0; ks < 2; ++ks) { if (ks == 0 || tr >= 2) {
                const u32x2 a0 = *(const LAS u32x2*)(L + RL_VT + (16 * vt + fr) * RQ_PT + (32 * ks + 4 * fq) * 2), a1 = *(const LAS u32x2*)(L + RL_VT + (16 * vt + fr) * RQ_PT + (32 * ks + 16 + 4 * fq) * 2);
                const u32x4 a4 = {a0.x, a0.y, a1.x, a1.y};
                o = __builtin_amdgcn_mfma_f32_16x16x32_bf16(__builtin_bit_cast(bf16x8, a4), pf[ks], o, 0, 0, 0); } }
#pragma unroll
            for (int ks = 0; ks < 4; ++ks) { const bf16x8 a = *(const LAS bf16x8*)(L + RL_ST + (16 * vt + fr) * RQ_PQ + ks * 64 + fq * 16);
                o = __builtin_amdgcn_mfma_f32_16x16x32_bf16(a, bqf[ks], o, 0, 0, 0); }
            *(u32x2*)(OB + trow * D + ocol + 16 * vt + 4 * fq) = (u32x2){pk2(o[0], o[1]), pk2(o[2], o[3])}; }
#if MK_FP8 && MK_GU_IN_P2
        GU_FILL_ISSUE_PART(((n > MK_GU_P2_SKIP ? n : MK_GU_P2_SKIP) - MK_GU_P2_SKIP) * FNGW + fgw, MK_GU_SPLIT, 16);
#endif
        bf16x8 ktf[2];
#pragma unroll
        for (int ks = 0; ks < 2; ++ks) ktf[ks] = *(const LAS bf16x8*)(L + RL_KT + (16 * w + fr) * RQ_PT + ks * 64 + fq * 16);
#pragma unroll
        for (int vt = 0; vt < 8; ++vt) { f32x4 ds = {0.f, 0.f, 0.f, 0.f};
#pragma unroll
            for (int ks = 0; ks < 2; ++ks) { const bf16x8 bv = *(const LAS bf16x8*)(L + RL_VT + (16 * vt + fr) * RQ_PT + ks * 64 + fq * 16);
                ds = __builtin_amdgcn_mfma_f32_16x16x32_bf16(ktf[ks], bv, ds, 0, 0, 0); }
            st[vt] = st[vt] * dl + ds * dr; }
        LDS_WAIT();
    }
#if MK_FP8 && MK_GU_IN_P2
    GU_FILL_STORE((31 - MK_GU_P2_SKIP) * FNGW + fgw);
    for (int it = GU_ITEMS + fgw; it < GU_ITEMS; it += FNGW) { GU_FILL_ISSUE(it); GU_FILL_STORE(it); }
#endif
    __syncthreads();
}

__device__ __forceinline__ void p3_combine(Frame& F) {
    const int gw = F.vcu * NWAVES + F.wave, NGW = F.G * NWAVES, lane = F.lane;
    const bf16_t* Z = WSP(bf16_t, WS_ZB); const bf16_t* OB = WSP(bf16_t, WS_OBUF); const bf16_t* OB2 = WSP(bf16_t, WS_OBUF2);
    for (int tok = gw; tok < NTOK; tok += NGW) {
#pragma unroll
        for (int mx = 0; mx < 2; ++mx) {
            const u32x4* op = (const u32x4*)(OB + (size_t)tok * D + mx * 1024 + 16 * lane); const u32x4* op2 = (const u32x4*)(OB2 + (size_t)tok * D + mx * 1024 + 16 * lane);
            const u32x4 a0 = __builtin_nontemporal_load(op), a1 = __builtin_nontemporal_load(op + 1), b0 = __builtin_nontemporal_load(op2), b1 = __builtin_nontemporal_load(op2 + 1);
            const unsigned aw[8] = {a0.x, a0.y, a0.z, a0.w, a1.x, a1.y, a1.z, a1.w}, bw[8] = {b0.x, b0.y, b0.z, b0.w, b1.x, b1.y, b1.z, b1.w};
            f32x4 v[4]; float s = 0.f;
#pragma unroll
            for (int j = 0; j < 4; ++j) { v[j] = (f32x4){bf_lo(aw[2 * j]) + bf_lo(bw[2 * j]), bf_hi(aw[2 * j]) + bf_hi(bw[2 * j]), bf_lo(aw[2 * j + 1]) + bf_lo(bw[2 * j + 1]), bf_hi(aw[2 * j + 1]) + bf_hi(bw[2 * j + 1])};
                s += (v[j].x * v[j].x + v[j].y * v[j].y) + (v[j].z * v[j].z + v[j].w * v[j].w); }
            s += __shfl_xor(s, 1); s += __shfl_xor(s, 2); s += __shfl_xor(s, 4); if (mx) s += __shfl_xor(s, 8);
            const float r = rsqrtf(s * (mx ? 1.f / 256.f : 1.f / 128.f) + RMS_EPS);
            const float* gp = (mx ? F.gla_norm_g + ((16 * lane) & 255) : F.hg_norm_g + ((16 * lane) & 127));
            const u32x4* zp = (const u32x4*)(Z + (size_t)tok * NZ + (mx ? Z_GR : Z_HOG) + 16 * lane); const u32x4 z0 = zp[0], z1 = zp[1];
            const unsigned za[8] = {z0.x, z0.y, z0.z, z0.w, z1.x, z1.y, z1.z, z1.w}; unsigned ow[8];
#pragma unroll
            for (int j = 0; j < 4; ++j) { const f32x4 gg = *(const f32x4*)(gp + 4 * j);
                float g0 = bf_lo(za[2 * j]), g1 = bf_hi(za[2 * j]), g2 = bf_lo(za[2 * j + 1]), g3 = bf_hi(za[2 * j + 1]);
#if MK_SILU_P3
                g0 *= fsigm(g0); g1 *= fsigm(g1); g2 *= fsigm(g2); g3 *= fsigm(g3);
#endif
                ow[2 * j] = pk2(v[j].x * r * gg.x * g0, v[j].y * r * gg.y * g1); ow[2 * j + 1] = pk2(v[j].z * r * gg.z * g2, v[j].w * r * gg.w * g3); }
#if MK_FP8_PO
            unsigned o8[4];
#pragma unroll
            for (int j = 0; j < 4; ++j) { const unsigned t8 = __builtin_amdgcn_cvt_pk_fp8_f32(bf_lo(ow[2 * j]), bf_hi(ow[2 * j]), 0u, false); o8[j] = __builtin_amdgcn_cvt_pk_fp8_f32(bf_lo(ow[2 * j + 1]), bf_hi(ow[2 * j + 1]), t8, true); }
            *(u32x4*)(WSP(unsigned char, mx ? WS_YB : WS_YA) + (size_t)tok * 1024 + 16 * lane) = (u32x4){o8[0], o8[1], o8[2], o8[3]};
#else
            u32x4* yo = (u32x4*)(WSP(bf16_t, mx ? WS_YB : WS_YA) + (size_t)tok * 1024 + 16 * lane);
            yo[0] = (u32x4){ow[0], ow[1], ow[2], ow[3]}; yo[1] = (u32x4){ow[4], ow[5], ow[6], ow[7]};
#endif
        }
    }
}

constexpr int R_HN = 0, R_PART = 65536, R_LOG = R_PART + 8 * 8 * 32 * 4, R_TK = R_LOG + 8 * 32 * 4, R_CNT = R_TK + 4096;
static_assert(R_CNT + 256 <= RING_BYTES, "router LDS map");
#ifndef MK_H1_P6
#define MK_H1_P6 1
#endif
__device__ __forceinline__ void p6_router(Frame& F) {
    LAS unsigned char* L = F.lds; const int tid = F.tid, lane = F.lane, w = F.wave;
    LAS float* hnl = (LAS float*)(L + R_HN); LAS float* part = (LAS float*)(L + R_PART); LAS float* logit = (LAS float*)(L + R_LOG);
    LAS int* tk_idx = (LAS int*)(L + R_TK); LAS float* tk_p = (LAS float*)(L + R_TK + 1024);
    LAS int* lcnt = (LAS int*)(L + R_CNT); LAS int* lbase = lcnt + 32;
    const int eq = tid & 7, ds = tid >> 3;
    f32x4 wreg[32];
#pragma unroll
    for (int j = 0; j < 32; ++j) wreg[j] = *(const f32x4*)(F.router_w + (size_t)(ds * 32 + j) * NE + 4 * eq);
    const int TPW = NTOK / F.G;
    if (tid < 32) lcnt[tid] = 0;
    const bf16_t* MIX = WSP(bf16_t, WS_H1); bf16_t* HN = WSP(bf16_t, WS_XN);
    const f32x4* gr = (const f32x4*)F.norm2_g + lane;
    f32x4 vn[8];
#if MK_H1_BF16
#define P6_LOAD_ROW(tok_) do { const u32x2* mr_ = (const u32x2*)(MIX + (size_t)(tok_) * D) + lane; \
        _Pragma("unroll") for (int j = 0; j < 8; ++j) { const u32x2 mv_ = mr_[64 * j]; vn[j] = (f32x4){bf_lo(mv_.x), bf_hi(mv_.x), bf_lo(mv_.y), bf_hi(mv_.y)}; } } while (0)
#else
#define P6_LOAD_ROW(tok_) do { const f32x4* xr_ = (const f32x4*)(F.x + (size_t)(tok_) * D) + lane; const u32x2* mr_ = (const u32x2*)(MIX + (size_t)(tok_) * D) + lane; \
        _Pragma("unroll") for (int j = 0; j < 8; ++j) { const f32x4 xv_ = xr_[64 * j]; const u32x2 mv_ = mr_[64 * j]; vn[j] = (f32x4){xv_.x + bf_lo(mv_.x), xv_.y + bf_hi(mv_.x), xv_.z + bf_lo(mv_.y), xv_.w + bf_hi(mv_.y)}; } } while (0)
#endif
    P6_LOAD_ROW(F.vcu * TPW + w);
#pragma unroll 1
    for (int bt = 0; bt < TPW / 8; ++bt) {
        const int tok = F.vcu * TPW + bt * 8 + w;
        {
            float s = 0.f;
#pragma unroll
            for (int j = 0; j < 8; ++j) s += (vn[j].x * vn[j].x + vn[j].y * vn[j].y) + (vn[j].z * vn[j].z + vn[j].w * vn[j].w);
            const float r = rsqrtf(wave_sum(s) * (1.f / D) + RMS_EPS);
            u32x2* o8 = (u32x2*)(HN + (size_t)tok * D) + lane;
#pragma unroll
            for (int j = 0; j < 8; ++j) { const f32x4 gg = gr[64 * j]; const f32x4 y = {vn[j].x * r * gg.x, vn[j].y * r * gg.y, vn[j].z * r * gg.z, vn[j].w * r * gg.w};
                *(LAS f32x4*)(hnl + w * 2048 + 4 * (lane + 64 * j)) = y;
#if MK_H1_P6
                ((u32x2*)(WSP(bf16_t, WS_H1) + (size_t)tok * D) + lane)[64 * j] = (u32x2){pk2(vn[j].x, vn[j].y), pk2(vn[j].z, vn[j].w)};
#endif
#if MK_FP8
                unsigned w8 = __builtin_amdgcn_cvt_pk_fp8_f32(y.x, y.y, 0u, false); w8 = __builtin_amdgcn_cvt_pk_fp8_f32(y.z, y.w, w8, true);
                ((unsigned*)((unsigned char*)HN + (size_t)tok * D))[lane + 64 * j] = w8; (void)o8;
#else
                u32x2 ww; ww.x = pk2(y.x, y.y); ww.y = pk2(y.z, y.w); o8[64 * j] = ww;
#endif
            }
        }
        LDS_WAIT(); __syncthreads();
        if (bt + 1 < TPW / 8) P6_LOAD_ROW(tok + 8);
#pragma unroll 2
        for (int t8 = 0; t8 < 8; ++t8) { f32x4 a = {0.f, 0.f, 0.f, 0.f}; const LAS f32x4* hp = (const LAS f32x4*)(hnl + t8 * 2048 + ds * 32);
#pragma unroll
            for (int j = 0; j < 8; ++j) { const f32x4 hv = hp[j]; a += wreg[4 * j] * hv.x; a += wreg[4 * j + 1] * hv.y; a += wreg[4 * j + 2] * hv.z; a += wreg[4 * j + 3] * hv.w; }
#pragma unroll
            for (int i = 0; i < 4; ++i) { float x = a[i]; x += __shfl_xor(x, 8); x += __shfl_xor(x, 16); x += __shfl_xor(x, 32); a[i] = x; }
            if (lane < 8) *(LAS f32x4*)(part + (t8 * 8 + w) * 32 + 4 * eq) = a; }
        LDS_WAIT(); __syncthreads();
        if (tid < 256) { const int t8 = tid >> 5, e = tid & 31; float a = F.router_b[e];
#pragma unroll
            for (int d2 = 0; d2 < 8; ++d2) a += part[(t8 * 8 + d2) * 32 + e];
            logit[t8 * 32 + e] = a; }
        LDS_WAIT(); __syncthreads();
        if (tid < 8) { float val[4]; int idx[4]; unsigned used = 0u;
            for (int k = 0; k < 4; ++k) { float best = -3.4e38f; int bi = 0; for (int i = 0; i < 32; ++i) { const float v = logit[tid * 32 + i]; if (!((used >> i) & 1u) && v > best) { best = v; bi = i; } } used |= 1u << bi; val[k] = best; idx[k] = bi; }
            float p[4], s = 0.f; for (int k = 0; k < 4; ++k) { p[k] = __expf(val[k] - val[0]); s += p[k]; }
            const float inv = 1.f / s;
            for (int k = 0; k < 4; ++k) { const int slot = (bt * 8 + tid) * 4 + k; tk_idx[slot] = idx[k]; tk_p[slot] = p[k] * inv; } }
    }
    LDS_WAIT(); __syncthreads();
    const int npair = TPW * 4;
    int my_e = 0, my_lr = 0;
    if (tid < npair) { my_e = tk_idx[tid]; my_lr = __hip_atomic_fetch_add(lcnt + my_e, 1, __ATOMIC_RELAXED, __HIP_MEMORY_SCOPE_WORKGROUP); }
    LDS_WAIT(); __syncthreads();
    if (tid < 32) lbase[tid] = (int)__hip_atomic_fetch_add((unsigned*)F.ctl + CW_ECNT + 64 * tid, (unsigned)lcnt[tid], __ATOMIC_RELAXED, __HIP_MEMORY_SCOPE_AGENT);
    LDS_WAIT(); __syncthreads();
    if (tid < npair) { const int rank = lbase[my_e] + my_lr; const int tok = F.vcu * TPW + (tid >> 2);
        WSP(int, WS_ROWTOK)[(size_t)my_e * NTOK + rank] = tok; WSP(float, WS_ROWW)[(size_t)my_e * NTOK + rank] = tk_p[tid]; WSP(int, WS_PAIR)[tok * 4 + (tid & 3)] = (my_e << 16) | rank; }
}
__device__ __forceinline__ void build_tab(Frame& F) {
    volatile LAS int* tab = (volatile LAS int*)(F.lds + LDS_TAB);
    if (F.tid < 32) { const int c = (int)__hip_atomic_load((unsigned*)F.ctl + CW_ECNT + 64 * F.tid, __ATOMIC_RELAXED, __HIP_MEMORY_SCOPE_AGENT); tab[F.tid] = c; tab[32 + F.tid] = (c + 255) >> 8; }
    LDS_WAIT(); __syncthreads();
    if (F.tid == 0) { int a = 0; for (int e = 0; e < NE; ++e) { tab[64 + e] = a; a += tab[32 + e]; } tab[96] = a; tab[100] = a; }
    LDS_WAIT(); __syncthreads();
    if (F.tid < 320) { int e = 0; while (e < NE - 1 && F.tid >= tab[64 + e + 1]) ++e; tab[128 + F.tid] = e; }
#if MK_HALF_TILES
    if (F.tid < 32) { const int c = tab[F.tid], nm = tab[32 + F.tid]; const int hf = (nm > 0 && c - 256 * (nm - 1) <= 128) ? 1 : 0; tab[TAB_NMF + F.tid] = nm - hf; }
    LDS_WAIT(); __syncthreads();
    if (F.tid == 0) { int a = 0, h = 0; for (int e = 0; e < NE; ++e) { tab[TAB_TBF + e] = a; a += tab[TAB_NMF + e]; if (tab[TAB_NMF + e] != tab[32 + e]) tab[TAB_HIDX + h++] = e; } tab[TAB_TBF + NE] = a; tab[TAB_NTF] = a; tab[TAB_NTH] = h; }
    LDS_WAIT(); __syncthreads();
    if (F.tid < 320) { int e = 0; while (e < NE - 1 && F.tid >= tab[TAB_TBF + e + 1]) ++e; tab[TAB_EOF + F.tid] = e; }
#endif
    LDS_WAIT(); __syncthreads();
}
__device__ __forceinline__ void p9_final(Frame& F) {
    const int gw = F.vcu * NWAVES + F.wave, NGW = F.G * NWAVES, lane = F.lane;
    const volatile LAS int* tab = (const volatile LAS int*)(F.lds + LDS_TAB);
    const bf16_t* MIX = WSP(bf16_t, WS_H1); const unsigned char* YP = WSP(unsigned char, WS_YPAIR); const int* PR = WSP(int, WS_PAIR);
    for (int tok = gw; tok < NTOK; tok += NGW) {
        f32x4 v[8]; const f32x4* hr = (const f32x4*)(F.x + (size_t)tok * D) + lane; const u32x2* mr = (const u32x2*)(MIX + (size_t)tok * D) + lane;
#if MK_H1_BF16 || MK_H1_P6
#pragma unroll
        for (int j = 0; j < 8; ++j) { const u32x2 mv = __builtin_nontemporal_load(mr + 64 * j); v[j] = (f32x4){bf_lo(mv.x), bf_hi(mv.x), bf_lo(mv.y), bf_hi(mv.y)}; }
        (void)hr;
#else
#pragma unroll
        for (int j = 0; j < 8; ++j) { const f32x4 xv = __builtin_nontemporal_load(hr + 64 * j); const u32x2 mv = __builtin_nontemporal_load(mr + 64 * j); v[j] = (f32x4){xv.x + bf_lo(mv.x), xv.y + bf_hi(mv.x), xv.z + bf_lo(mv.y), xv.w + bf_hi(mv.y)}; }
#endif
#pragma unroll
        for (int k = 0; k < 4; ++k) { const int pr = PR[tok * 4 + k]; const int e = pr >> 16, rank = pr & 0xffff; const size_t pos = (size_t)tab[64 + e] * 256 + rank;
            const unsigned* yr = (const unsigned*)(YP + pos * D) + lane;
#pragma unroll
            for (int j = 0; j < 8; ++j) { const unsigned y = __builtin_nontemporal_load(yr + 64 * j);
                v[j].x += __builtin_amdgcn_cvt_f32_fp8(y, 0) * 0.0625f; v[j].y += __builtin_amdgcn_cvt_f32_fp8(y, 1) * 0.0625f; v[j].z += __builtin_amdgcn_cvt_f32_fp8(y, 2) * 0.0625f; v[j].w += __builtin_amdgcn_cvt_f32_fp8(y, 3) * 0.0625f; } }
        float s = 0.f;
#pragma unroll
        for (int j = 0; j < 8; ++j) s += (v[j].x * v[j].x + v[j].y * v[j].y) + (v[j].z * v[j].z + v[j].w * v[j].w);
        const float r = rsqrtf(wave_sum(s) * (1.f / D) + RMS_EPS);
        f32x4* o = (f32x4*)(F.out + (size_t)tok * D) + lane; const f32x4* gr = (const f32x4*)F.final_g + lane;
#pragma unroll
        for (int j = 0; j < 8; ++j) { const f32x4 gg = gr[64 * j]; o[64 * j] = (f32x4){v[j].x * r * gg.x, v[j].y * r * gg.y, v[j].z * r * gg.z, v[j].w * r * gg.w}; }
    }
}

#ifndef MK_P2_VCU
#define MK_P2_VCU 0
#endif
#ifndef MK_P1_STAGGER
#define MK_P1_STAGGER 0
#endif
struct Args { Params p; int ph_lo, ph_hi; };
constexpr int N_PHASES = 10;

__global__ void __launch_bounds__(NTHREADS, 2) mk_fwd(Args args) {
    extern __shared__ __attribute__((aligned(16))) unsigned char lds_raw[];
    Frame F;
    F.lds = (LAS unsigned char*)lds_raw;
    F.tid = threadIdx.x; F.lane = F.tid & 63; F.wave = __builtin_amdgcn_readfirstlane(F.tid >> 6);
    F.G = gridDim.x; { const int bx = blockIdx.x; F.vcu = (F.G % 8 == 0) ? (bx % 8) * (F.G / 8) + bx / 8 : bx; }
    const Params& P = args.p;
    F.x = P.in[0]; F.norm1_g = P.in[1]; F.w_in = P.in[2]; F.lb_logits = P.in[3]; F.hg_norm_g = P.in[4]; F.gla_w2 = P.in[5]; F.gla_b = P.in[6]; F.gla_norm_g = P.in[7];
    F.w_proj_a = P.in[8]; F.w_proj_b = P.in[9]; F.w_out = P.in[10]; F.norm2_g = P.in[11]; F.router_w = P.in[12]; F.router_b = P.in[13]; F.w_gate_up = P.in[14];
    F.b_gate_up = P.in[15]; F.w_down = P.in[16]; F.b_down = P.in[17]; F.final_g = P.in[18];
    F.out = P.out; F.ws = P.ws; F.ctl = (unsigned*)(P.ws + WS_CTL);
    for (int u = F.tid; u < (LDS_BYTES - RING_BYTES) / 4; u += NTHREADS) ((LAS unsigned*)(F.lds + RING_BYTES))[u] = 0u;
    __syncthreads();
    const int lo = args.ph_lo, hi = args.ph_hi;
    const bool use_bar = (hi - lo) > 1;
    XcdBarrier bar; bar.bar = F.ctl + CW_BAR; bar.x = 0; bar.st = nullptr;
    if (use_bar) bar = xcd_barrier_post(F.ctl + CW_BAR, (volatile LAS unsigned*)(F.lds + LDS_XB));
#ifdef MK_ONLYMASK
#define IN(k) (((MK_ONLYMASK >> (k)) & 1) && lo <= (k) && (k) < hi)
#else
#define IN(k) (lo <= (k) && (k) < hi)
#endif
#define SEAM(k) do { if (IN(k) && IN((k) + 1)) xcd_barrier(bar); } while (0)
    const int c = (int)blockIdx.x;
    if (IN(0)) { p0_prologue(F); } SEAM(0);
    if (IN(1)) {
        p1_gates(F, F.vcu, F.G);
#if MK_FP8_MG
        constexpr int NT_F8 = in_tiles_f8(), NT_BF = 48 - NT_F8;
        { InSched S{WSP(bf16_t, WS_XN), WSP(bf16_t, WS_WINT), NTOK / 256, NT_BF, F.G, c, 2 * D, 0};
          typedef EpiInProjT<(MK_ROWS64 != 0) && (MK_G8 != 0) && !MK_FP8_VG> EpiInBf; EpiInBf E{WSP(bf16_t, WS_ZB), WSP(float, WS_LB), 0, WSP(unsigned char, WS_G8)};
#if MK_FP8 && MK_DN_FILL
          DownFill FL{F.w_down, WSP(unsigned char, WS_WDNT), 0, F.G * NWAVES, F.vcu * NWAVES + F.wave, F.lane};
          pg8::gemm_phase<EpiInBf, InSched, false, DownFill, pg8::NoKFill, false, (MK_EPI_RELAX & 1) != 0>(F.lds, 2 * D, S, E, FL); }
#else
          pg8::gemm_phase(F.lds, 2 * D, S, E); }
#endif
        { InSched S{F.ws + WS_XN8, F.ws + WS_WINT8 - (MK_FP8_VG ? (size_t)0 : (size_t)Z_MGA * D), NTOK / 256, NT_F8, F.G, c, D, 1};
          EpiInProj E{WSP(bf16_t, WS_ZB), WSP(float, WS_LB), 0, WSP(unsigned char, WS_G8)};
#if MK_FP8 && MK_DN_FILL
          DownFill FL{F.w_down, WSP(unsigned char, WS_WDNT), NT_BF / 4, F.G * NWAVES, F.vcu * NWAVES + F.wave, F.lane};
          pg8::gemm_phase<EpiInProj, InSched, true, DownFill, pg8::NoKFill, false, (MK_EPI_RELAX & 2) != 0>(F.lds, D, S, E, FL); }
#else
          pg8::gemm_phase<EpiInProj, InSched, true>(F.lds, D, S, E); }
#endif
#else
        DenseSched S{WSP(bf16_t, WS_XN), WSP(bf16_t, WS_WINT), NTOK / 256, NZ / 256, F.G, c, 2 * D};
        EpiInProj E{WSP(bf16_t, WS_ZB), WSP(float, WS_LB), 0, WSP(unsigned char, WS_G8)};
        pg8::gemm_phase(F.lds, 2 * D, S, E);
#endif
    } SEAM(1);
    if (IN(2)) { for (int item = MK_P2_VCU ? F.vcu : c; item < 256; item += F.G) recur_item(F, item); } SEAM(2);
    if (IN(3)) { p3_combine(F); } SEAM(3);
    if (IN(4)) {
        constexpr int PO_RB = MK_FP8_PO ? 1024 : 2048;
        MergeSched S{WSP(bf16_t, WS_YA), WSP(bf16_t, WS_WPAT), (long)(WS_YB - WS_YA), (long)(WS_WPBT - WS_WPAT), NTOK / 256, D / 256, F.G, c, PO_RB};
        EpiMerge E{WSP(bf16_t, WS_ZB), WSP(bf16_t, WS_MERGED), WSP(const unsigned char, WS_G8)};
#if 0
#elif MK_FP8 && MK_DN_FILL
        DownFill FL{F.w_down, WSP(unsigned char, WS_WDNT), 12, F.G * NWAVES, F.vcu * NWAVES + F.wave, F.lane};
        pg8::gemm_phase<EpiMerge, MergeSched, (MK_FP8_PO != 0), DownFill, pg8::NoKFill, false, (MK_EPI_RELAX & 4) != 0>(F.lds, PO_RB, S, E, FL);
#else
        pg8::gemm_phase(F.lds, 2048, S, E);
#endif
    } SEAM(4);
    if (IN(5)) {
        DenseSched S{WSP(bf16_t, WS_MERGED), WSP(bf16_t, WS_WOUTT), NTOK / 256, D / 256, F.G, c, MK_FP8_PO ? D : 2 * D};
        EpiMix E{WSP(bf16_t, WS_H1), F.x};
#if MK_FP8 && MK_DN_FILL && !MK_H1_BF16
        DownFill FL{F.w_down, WSP(unsigned char, WS_WDNT), 16, F.G * NWAVES, F.vcu * NWAVES + F.wave, F.lane};
        pg8::gemm_phase<EpiMix, DenseSched, (MK_FP8_PO != 0), DownFill, pg8::NoKFill, false, (MK_EPI_RELAX & 8) != 0>(F.lds, MK_FP8_PO ? D : 2 * D, S, E, FL);
#else
        pg8::gemm_phase(F.lds, 2 * D, S, E);
#endif
    } SEAM(5);
    if (IN(6)) { p6_router(F); } SEAM(6);
    if (IN(7) || IN(8) || IN(9)) build_tab(F);
    if (IN(7)) {
        GuSched S{WSP(bf16_t, WS_XN), WSP(bf16_t, WS_WGUT), WSP(int, WS_ROWTOK), (const volatile LAS int*)(F.lds + LDS_TAB), F.lds, F.G, c, MOE_RB, F.tid};
        EpiGU E{WSP(bf16_t, WS_ACT), F.b_gate_up};
#if MK_FP8 && MK_DN_FILL && MK_DN_FILL_P7
        DownFill FL{F.w_down, WSP(unsigned char, WS_WDNT), MK_H1_BF16 ? 16 : 18, F.G * NWAVES, F.vcu * NWAVES + F.wave, F.lane};
        pg8::gemm_phase<EpiGU, GuSched, true, DownFill, pg8::NoKFill, (MK_HALF_TILES != 0), (MK_EPI_RELAX & 16) != 0>(F.lds, MOE_RB, S, E, FL);
#else
        pg8::gemm_phase<EpiGU, GuSched, (MK_FP8 != 0)>(F.lds, MOE_RB, S, E);
#endif
    } SEAM(7);
    if (IN(8)) {
        DownSched S{WSP(bf16_t, WS_ACT), WSP(bf16_t, WS_WDNT), (const volatile LAS int*)(F.lds + LDS_TAB), F.G, c, MOE_RB};
        EpiDown E{WSP(unsigned char, WS_YPAIR), F.b_down, WSP(float, WS_ROWW)};
        pg8::gemm_phase<EpiDown, DownSched, (MK_FP8 != 0), pg8::NoFill, pg8::NoKFill, (MK_HALF_TILES != 0) || (MK_TAIL_SPLIT != 0), (MK_EPI_RELAX & 32) != 0>(F.lds, MOE_RB, S, E);
    } SEAM(8);
    if (IN(9)) { p9_final(F); }
#undef IN
#undef SEAM
}


#ifndef MK_N_LAUNCHES
#define MK_N_LAUNCHES 1
#endif
static void mk_forward(void* const* d_in, void* d_out, void* d_ws, hipStream_t stream) {
    static int ready = 0;
    if (!ready) { (void)hipFuncSetAttribute((const void*)mk_fwd, hipFuncAttributeMaxDynamicSharedMemorySize, LDS_BYTES); ready = 1; }
    (void)hipMemsetAsync((char*)d_ws + WS_CTL, 0, CTL_ZERO_BYTES, stream);
#ifdef MK_NANFILL
    (void)hipMemsetAsync((char*)d_ws + CTL_ZERO_BYTES, 0xFF, WS_END - CTL_ZERO_BYTES, stream);
#endif
    Args a; __builtin_memset(&a, 0, sizeof(a));
    for (int i = 0; i < 19; ++i) a.p.in[i] = (const float*)d_in[i];
    a.p.out = (float*)d_out; a.p.ws = (unsigned char*)d_ws;
    const int grid = 256;
#if MK_N_LAUNCHES == 1
    a.ph_lo = 0; a.ph_hi = N_PHASES;
    hipLaunchKernelGGL(mk_fwd, dim3(grid), dim3(NTHREADS), LDS_BYTES, stream, a);
#else
#ifndef MK_REPEAT_MASK
#define MK_REPEAT_MASK 0
#endif
    for (int ph = 0; ph < N_PHASES; ++ph) { a.ph_lo = ph; a.ph_hi = ph + 1; const int reps = ((MK_REPEAT_MASK >> ph) & 1) ? 4 : 1;
        for (int r = 0; r < reps; ++r) hipLaunchKernelGGL(mk_fwd, dim3(grid), dim3(NTHREADS), LDS_BYTES, stream, a); }
#endif
}

extern "C" void kernel_launch(void* const* d_in, const int* in_sizes, int n_in, void* d_out, int out_size, void* d_ws, size_t ws_size, hipStream_t stream) {
    (void)in_sizes; (void)n_in; (void)out_size; (void)ws_size;
    mk_forward(d_in, d_out, d_ws, stream);
}
```

```cpp
#include <hip/hip_runtime.h>
#include <stdint.h>
#define LAS __attribute__((address_space(3)))
#define GAS __attribute__((address_space(1)))
typedef unsigned short bf16_t;
typedef short bf16x8 __attribute__((ext_vector_type(8)));
typedef float f32x4 __attribute__((ext_vector_type(4)));
typedef float f32x2 __attribute__((ext_vector_type(2)));
typedef unsigned u32x4 __attribute__((ext_vector_type(4)));
typedef unsigned u32x2 __attribute__((ext_vector_type(2)));

typedef __bf16 bf16x2_t __attribute__((ext_vector_type(2)));
__device__ __forceinline__ unsigned cvt_pk_bf16(float lo, float hi) { const f32x2 v = {lo, hi}; const bf16x2_t b = __builtin_convertvector(v, bf16x2_t); return __builtin_bit_cast(unsigned, b); }
__device__ __forceinline__ unsigned pk2(float lo, float hi) { return cvt_pk_bf16(lo, hi); }
__device__ __forceinline__ unsigned f2bf(float f) { return cvt_pk_bf16(f, 0.f) & 0xffffu; }
__device__ __forceinline__ float bf_lo(unsigned w) { return __builtin_bit_cast(float, w << 16); }
__device__ __forceinline__ float bf_hi(unsigned w) { return __builtin_bit_cast(float, w & 0xffff0000u); }
__device__ __forceinline__ float fsigm(float x) { return __builtin_amdgcn_rcpf(1.f + __expf(-x)); }
typedef float f32x2 __attribute__((ext_vector_type(2)));
__device__ __forceinline__ f32x2 rcp2(f32x2 x) { return (f32x2){__builtin_amdgcn_rcpf(x.x), __builtin_amdgcn_rcpf(x.y)}; }
__device__ __forceinline__ f32x2 exp2v(f32x2 x) { return (f32x2){__builtin_amdgcn_exp2f(x.x), __builtin_amdgcn_exp2f(x.y)}; }
__device__ __forceinline__ f32x2 sigm2k(f32x2 x, float k) { return rcp2(exp2v(x * (f32x2){k, k}) + (f32x2){1.f, 1.f}); }
__device__ __forceinline__ float wave_sum(float v) {
#pragma unroll
    for (int o = 1; o < 64; o <<= 1) v += __shfl_xor(v, o);
    return v;
}

#define XB_TMO      128
#define XB_XCNT(j)  (256  + 64 * (j))
#define XB_XSUB(j)  (1280 + 64 * (j))
#define XB_XGEN(j)  (2304 + 64 * (j))
#define XB_TOP      3328
#define XB_TOPGEN   3392
#define XCD_BAR_WORDS 3456
#define XB_SPIN_CAP (1u << 18)
__device__ __forceinline__ unsigned xb_ld(unsigned* p)              { return __hip_atomic_load(p, __ATOMIC_RELAXED, __HIP_MEMORY_SCOPE_AGENT); }
__device__ __forceinline__ unsigned xb_add(unsigned* p, unsigned v) { return __hip_atomic_fetch_add(p, v, __ATOMIC_RELAXED, __HIP_MEMORY_SCOPE_AGENT); }
__device__ __forceinline__ unsigned xb_xcc_id() { return (unsigned)__builtin_amdgcn_s_getreg((3 << 11) | 20) & 0xFu; }
#define XB_SPIN(cond, bar) do { unsigned _sp = 0; while (cond) { __builtin_amdgcn_s_sleep(1); \
    if ((++_sp & 255u) == 0u) { if (xb_ld(&(bar)[XB_TMO])) break; if (_sp > XB_SPIN_CAP) { atomicAdd(&(bar)[XB_TMO], 1u); break; } } } } while (0)
struct XcdBarrier { unsigned* bar; unsigned x; volatile LAS unsigned* st; };
__device__ __forceinline__ XcdBarrier xcd_barrier_post(unsigned* bar, volatile LAS unsigned* st) {
    XcdBarrier b; b.bar = bar; b.x = xb_xcc_id(); b.st = st;
    if (threadIdx.x == 0) (void)xb_add(&bar[XB_XCNT(b.x)], 1u);
    return b;
}
__device__ __forceinline__ void xcd_barrier_complete(unsigned* bar, unsigned x, unsigned& nloc, unsigned& nx) {
    const unsigned G = gridDim.x * gridDim.y * gridDim.z;
    unsigned sum, cnt, mine, sp = 0u;
    for (;;) {
        sum = 0u; cnt = 0u; mine = 0u;
#pragma unroll
        for (unsigned j = 0; j < 16; ++j) { const unsigned c = xb_ld(&bar[XB_XCNT(j)]); sum += c; cnt += (c > 0u) ? 1u : 0u; mine = (j == x) ? c : mine; }
        if (sum == G) break;
        __builtin_amdgcn_s_sleep(1);
        if ((++sp & 255u) == 0u) { if (xb_ld(&bar[XB_TMO])) break; if (sp > XB_SPIN_CAP) { atomicAdd(&bar[XB_TMO], 1u); break; } }
    }
    nloc = mine > 0u ? mine : 1u; nx = cnt > 0u ? cnt : 1u;
}
__device__ __forceinline__ void xcd_barrier(const XcdBarrier& b) {
    asm volatile("s_waitcnt vmcnt(0)" ::: "memory");
    __syncthreads();
    if (threadIdx.x == 0) {
        unsigned* bar = b.bar;
        __builtin_amdgcn_s_waitcnt(0);
        unsigned nloc = b.st[0], nx = b.st[1];
        if (nloc == 0u) { xcd_barrier_complete(bar, b.x, nloc, nx); b.st[0] = nloc; b.st[1] = nx; }
        const unsigned old = xb_add(&bar[XB_XSUB(b.x)], 1u);
        const unsigned gen = old / nloc;
        if (old + 1u == (gen + 1u) * nloc) {
            __builtin_amdgcn_fence(__ATOMIC_RELEASE, "agent");
            asm volatile("s_waitcnt vmcnt(0)" ::: "memory");
            const unsigned og = xb_add(&bar[XB_TOP], 1u);
            const unsigned tg = og / nx;
            if (og + 1u == (tg + 1u) * nx) xb_add(&bar[XB_TOPGEN], 1u);
            else XB_SPIN(xb_ld(&bar[XB_TOPGEN]) == tg, bar);
            __builtin_amdgcn_fence(__ATOMIC_ACQUIRE, "agent");
            xb_add(&bar[XB_XGEN(b.x)], 1u);
            asm volatile("s_waitcnt vmcnt(0)" ::: "memory");
        } else {
            XB_SPIN(xb_ld(&bar[XB_XGEN(b.x)]) == gen, bar);
            __builtin_amdgcn_fence(__ATOMIC_ACQUIRE, "agent");
            asm volatile("s_waitcnt vmcnt(0)" ::: "memory");
        }
    }
    __syncthreads();
}

#ifndef MK_FILL_HOOK
#define MK_FILL_HOOK 0
#endif
#ifndef MK_EPI_RELAX
#define MK_EPI_RELAX 62
#endif
#ifndef MK_BF_ASM
#define MK_BF_ASM 0
#endif
#ifndef MK_BF_LASTPEEL
#define MK_BF_LASTPEEL 0
#endif
#ifndef MK_PRE_EARLY
#define MK_PRE_EARLY 3
#endif
#ifndef MK_EPI_PRESTAGE
#define MK_EPI_PRESTAGE 0
#endif
#ifndef MK_FILL_EARLY
#define MK_FILL_EARLY 0
#endif
#ifndef MK_FILL_ASM
#define MK_FILL_ASM ((MK_FILL_EARLY || MK_EPI_RELAX) ? 1 : 0)
#endif
#ifndef MK_TID_LAUNDER
#define MK_TID_LAUNDER 0
#endif
namespace pg8 {
constexpr int BM = 256, BK = 64, HALF = 128, HTB = HALF * BK * 2, STAGE_BYTES = 8 * HTB, NXCD = 8, WGM = 8;
__device__ __forceinline__ int lds_byte(int r, int c) { const int st = (r >> 4) * 2 + (c >> 5), rr = r & 15, cc = c & 31, ob = rr * 64 + cc * 2; return st * 1024 + (ob ^ (((ob >> 9) & 1) << 5)); }
__device__ __forceinline__ void stage_rc(int b, int& R, int& C) { const int st = b / 1024, sb = b % 1024, swz = sb ^ (((sb >> 9) & 1) << 5); R = (st >> 1) * 16 + swz / 64; C = (st & 1) * 32 + (swz % 64) / 2; }
__device__ __forceinline__ int perm32(int rho) { const int n = rho >> 4, i = rho & 15; return 8 * (i >> 2) + 4 * n + (i & 3); }

template <bool B> struct BoolC { static constexpr bool value = B; };
struct Unit { int pm, pn, aux, r0, half; };

__device__ __forceinline__ bool static_next(int nM, int nN, int G, int c, int i, int& pm, int& pn) {
    const int nwg = nM * nN; const long L = (long)i * G + c; if (L >= nwg) return false;
    int wgid = (int)L; { const int q = nwg / NXCD, r = nwg % NXCD, xcd = wgid % NXCD, off = wgid / NXCD; wgid = (xcd < r ? xcd * (q + 1) : r * (q + 1) + (xcd - r) * q) + off; }
    const int nig = WGM * nN, gid = wgid / nig, fm = gid * WGM, gsz = (nM - fm) < WGM ? (nM - fm) : WGM;
    pm = fm + ((wgid % nig) % gsz); pn = (wgid % nig) / gsz; return true;
}
__device__ __forceinline__ int xcd_remap(int L, int nwg) { const int q = nwg / NXCD, r = nwg % NXCD, xcd = L % NXCD, off = L / NXCD; return (xcd < r ? xcd * (q + 1) : r * (q + 1) + (xcd - r) * q) + off; }

typedef int v8i_t __attribute__((ext_vector_type(8)));
struct NoFill { static constexpr bool ON = false; static constexpr int NL = 2, NS = 0; template <int LO, int HI> __device__ __forceinline__ void issue_part(f32x4 (&)[2], int) const {} __device__ __forceinline__ void issue(f32x4 (&)[2], int) const {} __device__ __forceinline__ void consume(f32x4 (&)[2], int) const {} };
struct NoKFill { static constexpr bool ON = false; static constexpr int NL = 1, NS = 0; __device__ __forceinline__ void issue(f32x4 (&)[1], int) const {} __device__ __forceinline__ void consume(f32x4 (&)[1], int) const {} };
template <class Epi, class Sched, bool FP8 = false, class Fill = NoFill, class KF = NoKFill, bool HALFCAP = false, bool RELAX = false>
__device__ __forceinline__ int gemm_phase(LAS unsigned char* lds, const int RB, Sched& S, const Epi& E, const Fill& FL = Fill(), const KF& KFL = KF()) {
    int tid_ = threadIdx.x;
    if constexpr ((MK_TID_LAUNDER != 0) || (RELAX && !FP8)) asm volatile("" : "+v"(tid_));
    const int tid = tid_, wid = __builtin_amdgcn_readfirstlane(tid >> 6), lane = tid & 63, wr = wid >> 2, wc = wid & 3, fr = lane & 15, fq = lane >> 4;
    const int nt = RB / 128;
    int Rr[2], Cc[2]; unsigned voffB[2];
#pragma unroll
    for (int i = 0; i < 2; ++i) { int R, C; stage_rc(tid * 16 + i * 8192, R, C); Rr[i] = R; Cc[i] = C; const int Rb = Epi::brow(R); voffB[i] = (unsigned)(Rb * RB + C * 2); }
    const size_t kstep = (size_t)(BK * 2);
    const size_t hstep = (size_t)Epi::BHALF_ROWS * RB;
    const unsigned ldsw = (unsigned)wid * 1024u, ldsb = (unsigned)(size_t)lds;
    const int aoff = lds_byte(wr * 64 + fr, fq * 8), boff = lds_byte(wc * 32 + fr, fq * 8);
#define PG8_SA(b, h) (((b) * 2 + (h)) * HTB)
#define PG8_SB(b, h) ((4 + (b) * 2 + (h)) * HTB)
#define PG8_STAGE(bufoff, gbase, v0, v1) do { unsigned keep_; \
        asm volatile("s_mov_b32 %0, m0\n\ts_mov_b32 m0, %4\n\ts_nop 0\n\tglobal_load_lds_dwordx4 %1, %3\n\ts_add_u32 m0, m0, 0x2000\n\ts_nop 0\n\tglobal_load_lds_dwordx4 %2, %3\n\ts_mov_b32 m0, %0" \
            : "=&s"(keep_) : "v"(v0), "v"(v1), "s"((const char*)(gbase)), "s"(ldsb + (unsigned)(bufoff) + ldsw) : "memory", "scc"); } while (0)
#define PG8_STAGEB(bufoff, gbase) PG8_STAGE(bufoff, gbase, voffB[0], voffB[1])
#define PG8_LD8(addr) __builtin_shufflevector(*(const LAS u32x4*)(addr), *(const LAS u32x4*)((addr) + 1024), 0, 1, 2, 3, 4, 5, 6, 7)
#define PG8_LDA(dst, b, h) do { _Pragma("unroll") for (int m = 0; m < 4; ++m) dst[m] = PG8_LD8(lds + PG8_SA(b, h) + aoff + m * 2048); } while (0)
#define PG8_LDB(dst, b, h) do { _Pragma("unroll") for (int n = 0; n < 2; ++n) dst[n] = PG8_LD8(lds + PG8_SB(b, h) + boff + n * 2048); } while (0)
#define PG8_HALF(x, k) __builtin_bit_cast(bf16x8, __builtin_shufflevector(x, x, 4 * (k), 4 * (k) + 1, 4 * (k) + 2, 4 * (k) + 3))
#define PG8_MMA(ai, bj, At, Bt) do { __builtin_amdgcn_s_setprio(1); \
        if constexpr (!FP8 && (MK_BF_ASM != 0)) { _Pragma("unroll") for (int k_ = 0; k_ < 2; ++k_) _Pragma("unroll") for (int m = 0; m < 4; ++m) _Pragma("unroll") for (int n = 0; n < 2; ++n) { \
            const u32x4 b_ = k_ ? __builtin_shufflevector(Bt[n], Bt[n], 4, 5, 6, 7) : __builtin_shufflevector(Bt[n], Bt[n], 0, 1, 2, 3), a_ = k_ ? __builtin_shufflevector(At[m], At[m], 4, 5, 6, 7) : __builtin_shufflevector(At[m], At[m], 0, 1, 2, 3); \
            asm volatile("v_mfma_f32_16x16x32_bf16 %0, %1, %2, %0" : "+v"(acc[ai][bj][m][n]) : "v"(b_), "v"(a_)); } } else \
        _Pragma("unroll") for (int m = 0; m < 4; ++m) _Pragma("unroll") for (int n = 0; n < 2; ++n) { \
        if constexpr (FP8) { asm volatile("v_mfma_scale_f32_16x16x128_f8f6f4 %0, %1, %2, %0, %3, %4 op_sel_hi:[0,0,0]" : "+v"(acc[ai][bj][m][n]) : "v"(Bt[n]), "v"(At[m]), "v"(sc_w), "v"(sc_1)); } \
        else { acc[ai][bj][m][n] = __builtin_amdgcn_mfma_f32_16x16x32_bf16(PG8_HALF(Bt[n], 0), PG8_HALF(At[m], 0), acc[ai][bj][m][n], 0, 0, 0); \
               acc[ai][bj][m][n] = __builtin_amdgcn_mfma_f32_16x16x32_bf16(PG8_HALF(Bt[n], 1), PG8_HALF(At[m], 1), acc[ai][bj][m][n], 0, 0, 0); } } \
        __builtin_amdgcn_s_setprio(0); } while (0)
#define PG8_WAIT_V(n) asm volatile("s_waitcnt vmcnt(" #n ")" ::: "memory")
#define PG8_WAIT_VN(N) asm volatile("s_waitcnt vmcnt(%0)" :: "n"(N) : "memory")
#define PG8_WAIT_L(n) asm volatile("s_waitcnt lgkmcnt(" #n ")" ::: "memory")
#define PG8_BAR __builtin_amdgcn_s_barrier()
#define PG8_SCHED __builtin_amdgcn_sched_barrier(0)
    Unit cur, nxt; int ui = 0;
    if (!S.next(0, cur)) return 0;
    f32x4 acc[2][2][4][2];
#pragma unroll
    for (int a = 0; a < 2; ++a)
#pragma unroll
        for (int b = 0; b < 2; ++b)
#pragma unroll
            for (int m = 0; m < 4; ++m)
#pragma unroll
                for (int n = 0; n < 2; ++n) acc[a][b][m][n] = (f32x4){0.f, 0.f, 0.f, 0.f};
    typedef unsigned u32x8 __attribute__((ext_vector_type(8)));
    u32x8 At[4], B0[2], B1[2];
    f32x4 ff[Fill::NL];
    constexpr bool LP = (RELAX && (FP8 || (MK_BF_ASM != 0)) && (MK_PRE_EARLY != 0)) || ((MK_BF_LASTPEEL != 0) && !FP8 && !RELAX && Fill::ON && !KF::ON);
    constexpr bool PRE = RELAX && (MK_EPI_PRESTAGE != 0);
    constexpr int EA_ = (Fill::ON ? Fill::NL + Fill::NS : 0) + Epi::VM_MIN, EA = EA_ > 55 ? 55 : EA_;
    f32x4 kf[KF::NL]; int kfi = 0;
    const unsigned sc_w = 0x77777777u, sc_1 = 0x7f7f7f7fu;
    if (Sched::GATHER) { S.pre(cur, 0); PG8_WAIT_V(0); __syncthreads(); }
    unsigned vc[2][2];
    S.a_voff(cur, 0, vc, Rr, Cc, RB);
    const char* cA = S.a_base(cur); const char* cB = S.b_base(cur);
    PG8_STAGEB(PG8_SB(0, 0), cB); PG8_STAGEB(PG8_SB(0, 1), cB + hstep); PG8_STAGE(PG8_SA(0, 0), cA, vc[0][0], vc[0][1]); PG8_STAGE(PG8_SA(0, 1), cA, vc[1][0], vc[1][1]);
    if (wr == 1) PG8_BAR;
    PG8_WAIT_V(2); PG8_BAR;
    PG8_STAGEB(PG8_SB(1, 0), cB + kstep); PG8_STAGE(PG8_SA(1, 0), cA + kstep, vc[0][0], vc[0][1]); PG8_STAGEB(PG8_SB(1, 1), cB + hstep + kstep);
    if constexpr (PRE) PG8_STAGE(PG8_SA(1, 1), cA + kstep, vc[1][0], vc[1][1]);
    if constexpr (KF::ON || RELAX) PG8_WAIT_V(0); else PG8_WAIT_V(6);
    PG8_BAR;
    for (;;) {
        const bool has_next = S.next(ui + 1, nxt);
        const bool hf = HALFCAP && cur.half != 0;
        const char* nA = has_next ? S.a_base(nxt) : cA; const char* nB = has_next ? S.b_base(nxt) : cB;
#define PG8_KITER(T_, FE_, LE_) do { const int t = (T_); \
            const bool last = (t == nt - 2); \
            constexpr bool fe = RELAX && !KF::ON && (FE_); \
            if (Sched::GATHER) { if (t == nt - 4 && has_next) S.pre(nxt, ui + 1); } \
            unsigned vs[2][2]; \
_Pragma("unroll") \
            for (int h = 0; h < 2; ++h) \
_Pragma("unroll") \
                for (int i = 0; i < 2; ++i) vs[h][i] = vc[h][i]; \
            if (Sched::GATHER) { if (last && has_next) S.a_voff(nxt, ui + 1, vs, Rr, Cc, RB); } \
            const char* a1 = cA + (size_t)(t + 1) * kstep; \
            const char* a2 = last ? nA : cA + (size_t)(t + 2) * kstep; const char* b2 = last ? nB : cB + (size_t)(t + 2) * kstep; \
            const char* a3 = a2 + kstep; const char* b3 = b2 + kstep; \
            PG8_LDB(B0, 0, 0); PG8_LDB(B1, 0, 1); PG8_SCHED; PG8_LDA(At, 0, 0); if constexpr (!(fe && PRE)) PG8_STAGE(PG8_SA(1, 1), a1, vc[1][0], vc[1][1]); \
            if constexpr (fe) PG8_WAIT_VN(8 + EA); else PG8_WAIT_VN(8 + KF::NS); \
            PG8_WAIT_L(0); PG8_BAR; if constexpr (KF::ON) KFL.issue(kf, kfi); PG8_MMA(0, 0, At, B0); PG8_MMA(0, 1, At, B1); PG8_BAR; PG8_SCHED; \
            if (!hf) PG8_LDA(At, 0, 1); PG8_STAGEB(PG8_SB(0, 0), b2); PG8_STAGEB(PG8_SB(0, 1), b2 + hstep); PG8_STAGE(PG8_SA(0, 0), a2, vs[0][0], vs[0][1]); \
            if constexpr (fe) PG8_WAIT_VN(8 + EA); else PG8_WAIT_VN(8 + KF::NS + (KF::ON ? KF::NL : 0)); \
            PG8_WAIT_L(0); PG8_BAR; if (!hf) { PG8_MMA(1, 0, At, B0); PG8_MMA(1, 1, At, B1); } PG8_BAR; PG8_SCHED; \
            PG8_LDB(B0, 1, 0); PG8_LDB(B1, 1, 1); PG8_SCHED; PG8_LDA(At, 1, 0); PG8_STAGE(PG8_SA(0, 1), a2, vs[1][0], vs[1][1]); \
            if constexpr (fe && PRE) PG8_WAIT_VN(8 + EA); else PG8_WAIT_VN(8 + (KF::ON ? KF::NL : 0)); \
            PG8_WAIT_L(0); PG8_BAR; PG8_MMA(0, 0, At, B0); PG8_MMA(0, 1, At, B1); PG8_BAR; PG8_SCHED; \
            if (!hf) PG8_LDA(At, 1, 1); PG8_STAGEB(PG8_SB(1, 0), b3); PG8_STAGEB(PG8_SB(1, 1), b3 + hstep); PG8_STAGE(PG8_SA(1, 0), a3, vs[0][0], vs[0][1]); \
            if constexpr (KF::ON) { static_assert(KF::NL == 4, "kf tie"); asm volatile("s_waitcnt vmcnt(8)" : "+v"(kf[0]), "+v"(kf[1]), "+v"(kf[2]), "+v"(kf[3]) :: "memory"); } else PG8_WAIT_V(8); \
            PG8_WAIT_L(0); PG8_BAR; if constexpr (LP && (LE_)) { E.preload(epre, cur, wc, fq); if constexpr (Fill::ON && (MK_PRE_EARLY >= 2)) FL.template issue_part<0, (MK_PRE_EARLY == 2 ? Fill::NL : Fill::NL / 2)>(ff, ui); } \
            if (!hf) PG8_MMA(1, 0, At, B0); if constexpr (KF::ON) { KFL.consume(kf, kfi); ++kfi; } \
            if constexpr (LP && (LE_) && Fill::ON && (MK_PRE_EARLY == 4)) FL.template issue_part<Fill::NL / 2, Fill::NL>(ff, ui); \
            if (!hf) PG8_MMA(1, 1, At, B1); PG8_BAR; PG8_SCHED; \
            if (Sched::GATHER) { if (last) { \
_Pragma("unroll") \
                for (int h = 0; h < 2; ++h) \
_Pragma("unroll") \
                    for (int i = 0; i < 2; ++i) vc[h][i] = vs[h][i]; } } \
        } while (0)
        typename Epi::Pre epre;
        if constexpr (LP && !RELAX) { for (int t_ = 0; t_ < nt - 2; t_ += 2) PG8_KITER(t_, false, false); PG8_KITER(nt - 2, false, true); }
        else if constexpr (LP) { PG8_KITER(0, true, false); for (int t_ = 2; t_ < nt - 2; t_ += 2) PG8_KITER(t_, false, false); PG8_KITER(nt - 2, false, true); }
        else if constexpr (RELAX) { PG8_KITER(0, true, false); for (int t_ = 2; t_ < nt; t_ += 2) PG8_KITER(t_, false, false); }
        else { for (int t_ = 0; t_ < nt; t_ += 2) PG8_KITER(t_, false, false); }
#undef PG8_KITER
        if (wr == 0) PG8_BAR;
        if constexpr (PRE) { if (has_next) PG8_STAGE(PG8_SA(1, 1), nA + kstep, vc[1][0], vc[1][1]); }
        if constexpr (FP8 || (MK_BF_ASM != 0)) asm volatile("s_nop 15\n\ts_nop 15\n\ts_nop 15\n\ts_nop 15" ::: "memory");
        if constexpr (!LP) E.preload(epre, cur, wc, fq);
        if constexpr (Fill::ON && LP && (MK_PRE_EARLY == 3)) FL.template issue_part<Fill::NL / 2, Fill::NL>(ff, ui);
        else if constexpr (Fill::ON && !(LP && (MK_PRE_EARLY == 2 || MK_PRE_EARLY == 4))) FL.issue(ff, ui);
        epre.template ready<(Fill::ON && (MK_FILL_ASM != 0)) ? Fill::NL : 0>();
        const bool keep = E(acc, cur, wr, wc, fr, fq, epre);
#if MK_FILL_ASM
        if constexpr (Fill::ON) FL.template consume_w<Epi::VM_MIN>(ff, ui);
#else
        if constexpr (Fill::ON) FL.consume(ff, ui);
#endif
        if (!has_next) break;
        if (!keep) {
#pragma unroll
            for (int a = 0; a < 2; ++a)
#pragma unroll
                for (int b = 0; b < 2; ++b)
#pragma unroll
                    for (int m = 0; m < 4; ++m)
#pragma unroll
                        for (int n = 0; n < 2; ++n) acc[a][b][m][n] = (f32x4){0.f, 0.f, 0.f, 0.f};
        }
        cur = nxt; cA = nA; cB = nB; ++ui;
        if (wr == 1) PG8_BAR;
    }
    PG8_WAIT_V(0);
    PG8_BAR;
    return kfi;
#undef PG8_SA
#undef PG8_SB
#undef PG8_STAGE
#undef PG8_STAGEB
#undef PG8_LDA
#undef PG8_LDB
#undef PG8_MMA
#undef PG8_HALF
#undef PG8_LD8
#undef PG8_WAIT_V
#undef PG8_WAIT_VN
#undef PG8_WAIT_L
#undef PG8_BAR
#undef PG8_SCHED
}
}

constexpr int D = 2048, NTOK = 16384, TSEQ = 2048, NBATCH = 8, DIN = 12320, NE = 32, NZ = 12288;
constexpr int Z_HQ = 0, Z_HFF = 1024, Z_HFB = 2048, Z_HI = 3072, Z_HOG = 4096, Z_GQ = 5120, Z_GK = 5632, Z_GV = 6144, Z_GR = 7168, Z_MGA = 8192, Z_MGB = 10240;
constexpr float RMS_EPS = 1e-5f, QSCALE = 0.08838834764831845f;
constexpr int NWAVES = 8, NTHREADS = 512;
#ifndef MK_FP8
#define MK_FP8 1
#endif
constexpr int MOE_RB = MK_FP8 ? D : 2 * D;
#ifndef MK_GU_IN_P2
#define MK_GU_IN_P2 1
#endif
#ifndef MK_GU_KFILL
#define MK_GU_KFILL 0
#endif
#if MK_GU_KFILL
#undef MK_GU_IN_P2
#define MK_GU_IN_P2 0
#endif
#ifndef MK_GU_SPLIT
#define MK_GU_SPLIT 16
#endif
#ifndef MK_GU_PROBE
#define MK_GU_PROBE 0
#endif
#ifndef MK_GU_P2_SKIP
#define MK_GU_P2_SKIP 0
#endif
#ifndef MK_FP8_MG
#define MK_FP8_MG 1
#endif
constexpr size_t MiB = 1u << 20;
constexpr size_t WS_CTL = 0, CTL_ZERO_BYTES = 1 * MiB;
#ifndef MK_P6_XN
#define MK_P6_XN 1
#endif
constexpr size_t WS_RR = 1 * MiB + 524288;
constexpr size_t WS_LB = 1 * MiB, WS_W2T = 1 * MiB + 65536, WS_WLRT = 1 * MiB + 131072;
constexpr size_t WS_WINT = 2 * MiB, WS_WPAT = 50 * MiB, WS_WPBT = 54 * MiB, WS_WOUTT = 58 * MiB, WS_WGUT = 66 * MiB, WS_WDNT = 578 * MiB;
constexpr size_t WS_XN = 834 * MiB, WS_ZB = 898 * MiB, WS_GGLA = 1282 * MiB, WS_OBUF = 1314 * MiB, WS_YA = 1442 * MiB, WS_YB = 1474 * MiB, WS_MERGED = 1506 * MiB, WS_H1 = 1570 * MiB;
constexpr size_t WS_ROWTOK = 1698 * MiB, WS_ROWW = 1700 * MiB, WS_PAIR = 1702 * MiB, WS_ACT = 1704 * MiB, WS_YPAIR = 1992 * MiB, WS_OBUF2 = 2280 * MiB, WS_XN8 = 2344 * MiB, WS_END = 2408 * MiB;
#ifndef MK_FP8_PO
#define MK_FP8_PO 1
#endif
#ifndef MK_FP8_VG
#define MK_FP8_VG (MK_FP8_PO ? 0 : 1)
#endif
#if 0
#endif
#ifndef MK_G8
#define MK_G8 1
#endif
constexpr size_t WS_G8 = WS_END + 24 * MiB;
constexpr size_t WS_WINT8 = MK_FP8_VG ? WS_END : WS_WINT + 32 * MiB;
constexpr int CW_BAR = 4096, CW_ECNT = 8192;
constexpr int RING_BYTES = 131072, LDS_XB = RING_BYTES, LDS_LIST = RING_BYTES + 64, LDS_TAB = LDS_LIST + 2048, LDS_BYTES = 147456;
static_assert(LDS_TAB + 4 * (128 + 320) <= LDS_BYTES, "lds map");

struct Params { const float* in[19]; float* out; unsigned char* ws; };
struct Frame {
    LAS unsigned char* lds; int tid, lane, wave, vcu, G;
    const float *x, *norm1_g, *w_in, *lb_logits, *hg_norm_g, *gla_w2, *gla_b, *gla_norm_g, *w_proj_a, *w_proj_b, *w_out, *norm2_g, *router_w, *router_b, *w_gate_up, *b_gate_up, *w_down, *b_down, *final_g;
    float* out; unsigned char* ws; unsigned* ctl;
};
#define WSP(T, off) ((T*)(F.ws + (off)))

#ifndef MK_VG_MASK
#define MK_VG_MASK 15
#endif
__device__ __forceinline__ constexpr bool in_tile_is_f8(int t) { return t >= 32 || (MK_FP8_VG && (((MK_VG_MASK & 1) && t >= 12 && t < 16) || ((MK_VG_MASK & 2) && t >= 16 && t < 20) || ((MK_VG_MASK & 4) && t >= 24 && t < 28) || ((MK_VG_MASK & 8) && t >= 28 && t < 32))); }
__device__ __forceinline__ constexpr int in_tiles_f8() { int n = 0; for (int t = 0; t < 48; ++t) n += in_tile_is_f8(t) ? 1 : 0; return n; }
__device__ __forceinline__ int in_nth_tile(int j, bool f8) { int t = 0, k = -1;
#pragma unroll 1
    for (; t < 48; ++t) { if (in_tile_is_f8(t) == f8) { if (++k == j) break; } } return t; }
struct InSched {
    static constexpr bool GATHER = false;
    const void* A; const void* Bt; int nM, nN, G, c, RB, f8;
    __device__ __forceinline__ bool next(int i, pg8::Unit& u) const { u.aux = 0; u.r0 = 0; u.half = 0; const bool ok = pg8::static_next(nM, nN, G, c, i, u.pm, u.pn);
        if (MK_FP8_VG && MK_VG_MASK == 15) u.pn = f8 ? (u.pn < 8 ? u.pn + 12 : u.pn + 16) : (u.pn < 12 ? u.pn : u.pn + 8); else if (MK_FP8_VG) u.pn = in_nth_tile(u.pn, f8 != 0); else u.pn = f8 ? u.pn + 32 : u.pn;
        return ok; }
    __device__ __forceinline__ const char* a_base(const pg8::Unit& u) const { return (const char*)A + (size_t)u.pm * 256 * RB; }
    __device__ __forceinline__ const char* b_base(const pg8::Unit& u) const { return (const char*)Bt + (size_t)u.pn * 256 * RB; }
    __device__ __forceinline__ void a_voff(const pg8::Unit&, int, unsigned (&vo)[2][2], const int (&R)[2], const int (&C)[2], int K_) const {
#pragma unroll
        for (int h = 0; h < 2; ++h)
#pragma unroll
            for (int i = 0; i < 2; ++i) vo[h][i] = (unsigned)((h * 128 + R[i]) * K_ + C[i] * 2); }
    __device__ __forceinline__ void pre(const pg8::Unit&, int) const {}
};
struct DenseSched {
    static constexpr bool GATHER = false;
    const void* A; const void* Bt; int nM, nN, G, c, RB;
    __device__ __forceinline__ bool next(int i, pg8::Unit& u) const { u.aux = 0; u.r0 = 0; u.half = 0; return pg8::static_next(nM, nN, G, c, i, u.pm, u.pn); }
    __device__ __forceinline__ const char* a_base(const pg8::Unit& u) const { return (const char*)A + (size_t)u.pm * 256 * RB; }
    __device__ __forceinline__ const char* b_base(const pg8::Unit& u) const { return (const char*)Bt + (size_t)u.pn * 256 * RB; }
    __device__ __forceinline__ void a_voff(const pg8::Unit&, int, unsigned (&vo)[2][2], const int (&R)[2], const int (&C)[2], int K_) const {
#pragma unroll
        for (int h = 0; h < 2; ++h)
#pragma unroll
            for (int i = 0; i < 2; ++i) vo[h][i] = (unsigned)((h * 128 + R[i]) * K_ + C[i] * 2); }
    __device__ __forceinline__ void pre(const pg8::Unit&, int) const {}
};
struct MergeSched {
    static constexpr bool GATHER = false;
    const bf16_t *A0, *B0; long dA, dB; int nM, nN, G, c, RB;
    __device__ __forceinline__ bool next(int i, pg8::Unit& u) const { u.aux = i & 1; u.r0 = 0; u.half = 0; return pg8::static_next(nM, nN, G, c, i >> 1, u.pm, u.pn); }
    __device__ __forceinline__ const char* a_base(const pg8::Unit& u) const { return (const char*)A0 + (size_t)u.aux * dA + (size_t)u.pm * 256 * RB; }
    __device__ __forceinline__ const char* b_base(const pg8::Unit& u) const { return (const char*)B0 + (size_t)u.aux * dB + (size_t)u.pn * 256 * RB; }
    __device__ __forceinline__ void a_voff(const pg8::Unit&, int, unsigned (&vo)[2][2], const int (&R)[2], const int (&C)[2], int K_) const {
#pragma unroll
        for (int h = 0; h < 2; ++h)
#pragma unroll
            for (int i = 0; i < 2; ++i) vo[h][i] = (unsigned)((h * 128 + R[i]) * K_ + C[i] * 2); }
    __device__ __forceinline__ void pre(const pg8::Unit&, int) const {}
};
#ifndef MK_TAIL_SPLIT
#define MK_TAIL_SPLIT 1
#endif
#ifndef MK_HALF_TILES
#define MK_HALF_TILES 0
#endif
constexpr int TAB_NMF = 448, TAB_TBF = 480, TAB_NTF = 516, TAB_NTH = 517, TAB_HIDX = 520, TAB_EOF = 560;
static_assert(LDS_TAB + 4 * (TAB_EOF + 320) <= LDS_BYTES, "lds map (half tiles)");
__device__ __forceinline__ int tabr(const volatile LAS int* tab, int i) { return __builtin_amdgcn_readfirstlane(tab[i]); }
__device__ __forceinline__ int tab_expert_of_tile(const volatile LAS int* tab, int Tt) { return tabr(tab, 128 + Tt); }
struct GuSched {
    static constexpr bool GATHER = true;
    const void* A; const void* Bt; const int* rowtok; const volatile LAS int* tab; LAS unsigned char* lds; int G, c, RB, tid;
    __device__ __forceinline__ bool next(int i, pg8::Unit& u) const {
#if MK_HALF_TILES
        const int NTF = tabr(tab, TAB_NTF), nwgF = NTF * 16; const long L = (long)i * G + c;
        if (L < nwgF) { const int w = pg8::xcd_remap((int)L, nwgF); const int e = tabr(tab, TAB_EOF + (w >> 4));
            const int tbF = tabr(tab, TAB_TBF + e), local = w - 16 * tbF, nm = tabr(tab, TAB_NMF + e);
            u.pm = local % nm; u.pn = local / nm; u.aux = e; u.r0 = (tabr(tab, 64 + e) + u.pm) * 256; u.half = 0; return true; }
        const long Lh = L - nwgF; if (Lh >= (long)tabr(tab, TAB_NTH) * 16) return false;
        { const int e = tabr(tab, TAB_HIDX + (int)(Lh >> 4)); u.pm = tabr(tab, 32 + e) - 1; u.pn = (int)(Lh & 15); u.aux = e; u.r0 = (tabr(tab, 64 + e) + u.pm) * 256; u.half = 1; return true; }
#else
        const int NTt = tabr(tab, 100), nwg = NTt * 16; const long L = (long)i * G + c; if (L >= nwg) return false;
        const int w = pg8::xcd_remap((int)L, nwg);
        const int Tt = w >> 4; int e = tab_expert_of_tile(tab, Tt);
        const int tb = tabr(tab, 64 + e), local = w - 16 * tb, nm = tabr(tab, 32 + e);
        u.pm = local % nm; u.pn = local / nm; u.aux = e; u.r0 = (tb + u.pm) * 256; u.half = 0; return true;
#endif
    }
    __device__ __forceinline__ const char* a_base(const pg8::Unit&) const { return (const char*)A; }
    __device__ __forceinline__ const char* b_base(const pg8::Unit& u) const { return (const char*)Bt + ((size_t)u.aux * 4096 + (size_t)u.pn * 256) * RB; }
    __device__ __forceinline__ void pre(const pg8::Unit& u, int slot) const {
        if (tid < 256) __builtin_amdgcn_global_load_lds((const unsigned*)(rowtok + (size_t)u.aux * NTOK + u.pm * 256 + tid), (LAS unsigned*)(lds + LDS_LIST + (slot & 1) * 1024 + (tid >> 6) * 256), 4, 0, 0); }
    __device__ __forceinline__ void a_voff(const pg8::Unit& u, int slot, unsigned (&vo)[2][2], const int (&R)[2], const int (&C)[2], int K_) const {
        const volatile LAS int* lst = (const volatile LAS int*)(lds + LDS_LIST + (slot & 1) * 1024); const int n = tabr(tab, u.aux);
#pragma unroll
        for (int h = 0; h < 2; ++h)
#pragma unroll
            for (int i = 0; i < 2; ++i) { const int r = h * 128 + R[i]; int tok = lst[r]; if (u.pm * 256 + r >= n) tok = 0; vo[h][i] = (unsigned)(tok * K_ + C[i] * 2); } }
};
struct DownSched {
    static constexpr bool GATHER = false;
    const void* A; const void* Bt; const volatile LAS int* tab; int G, c, RB;
    __device__ __forceinline__ bool next(int i, pg8::Unit& u) const {
#if MK_HALF_TILES
        const int NTF = tabr(tab, TAB_NTF); int pf;
        if (pg8::static_next(NTF, 8, G, c, i, pf, u.pn)) { const int e = tabr(tab, TAB_EOF + pf); const int lp = pf - tabr(tab, TAB_TBF + e); u.pm = tabr(tab, 64 + e) + lp; u.aux = e; u.r0 = lp * 256; u.half = 0; return true; }
        const long Lh = (long)i * G + c - (long)NTF * 8; if (Lh < 0 || Lh >= (long)tabr(tab, TAB_NTH) * 8) return false;
        { const int e = tabr(tab, TAB_HIDX + (int)(Lh >> 3)); const int lp = tabr(tab, 32 + e) - 1; u.pm = tabr(tab, 64 + e) + lp; u.pn = (int)(Lh & 7); u.aux = e; u.r0 = lp * 256; u.half = 1; return true; }
#else
        const int NTt = tabr(tab, 100); u.half = 0;
#if MK_TAIL_SPLIT
        { const int U = NTt * 8, full = U / G, rem = U - full * G;
          if (i == full && rem > 0 && 2 * rem <= G) { if (c >= 2 * rem) return false;
              if (!pg8::static_next(NTt, 8, 1, full * G + (c >> 1), 0, u.pm, u.pn)) return false;
              u.half = 1 + (c & 1); const int e = tab_expert_of_tile(tab, u.pm); u.aux = e; u.r0 = (u.pm - tabr(tab, 64 + e)) * 256; return true; } }
#endif
        if (!pg8::static_next(NTt, 8, G, c, i, u.pm, u.pn)) return false;
        const int e = tab_expert_of_tile(tab, u.pm); u.aux = e; u.r0 = (u.pm - tabr(tab, 64 + e)) * 256; return true;
#endif
    }
    __device__ __forceinline__ const char* a_base(const pg8::Unit& u) const { return (const char*)A + ((size_t)u.pm * 256 + (u.half == 2 ? 128 : 0)) * RB; }
    __device__ __forceinline__ const char* b_base(const pg8::Unit& u) const { return (const char*)Bt + ((size_t)u.aux * 2048 + (size_t)u.pn * 256) * RB; }
    __device__ __forceinline__ void a_voff(const pg8::Unit&, int, unsigned (&vo)[2][2], const int (&R)[2], const int (&C)[2], int K_) const {
#pragma unroll
        for (int h = 0; h < 2; ++h)
#pragma unroll
            for (int i = 0; i < 2; ++i) vo[h][i] = (unsigned)((h * 128 + R[i]) * K_ + C[i] * 2); }
    __device__ __forceinline__ void pre(const pg8::Unit&, int) const {}
};

#ifndef MK_ROWS64
#define MK_ROWS64 1
#endif
#define ROWS_64    static constexpr int BHALF_ROWS = 32;  static __device__ __forceinline__ int brow(int R) { return 64 * (R >> 5) + 8 * ((R >> 2) & 3) + 4 * ((R >> 4) & 1) + (R & 3); }
#define ROWS_GU    static constexpr int BHALF_ROWS = 8;   static __device__ __forceinline__ int brow(int R) { return 64 * (R >> 5) + 16 * ((R >> 2) & 3) + 4 * ((R >> 4) & 1) + (R & 3); }
#ifndef MK_PK_EPI
#define MK_PK_EPI 1
#endif
#ifndef MK_SILU_P3
#define MK_SILU_P3 0
#endif
template <bool P64>
struct EpiInProjT {
    struct Pre { template <int NAFTER> __device__ __forceinline__ void ready() {} }; __device__ __forceinline__ void preload(Pre&, const pg8::Unit&, int, int) const {}
    static constexpr int BHALF_ROWS = P64 ? 32 : 8;
    static __device__ __forceinline__ int brow(int R) { return 64 * (R >> 5) + (P64 ? 8 : 16) * ((R >> 2) & 3) + 4 * ((R >> 4) & 1) + (R & 3); }
    static constexpr int BJS = P64 ? 32 : 8, FQS = P64 ? 8 : 16;
    static constexpr int VM_MIN = (MK_G8 && !P64) ? 8 : 32;
    bf16_t* Z; const float* lb; int coloff; unsigned char* g8;
    template <int KIND> __device__ __forceinline__ void run(f32x4 (&acc)[2][2][4][2], int row0, int col0, float sc) const {
        float lbv[2][8];
        if (KIND == 3) {
#pragma unroll
            for (int bj = 0; bj < 2; ++bj) { const f32x4 a = *(const f32x4*)(lb + col0 - 1024 + bj * BJS), b = *(const f32x4*)(lb + col0 - 1024 + bj * BJS + 4);
                lbv[bj][0] = a[0]; lbv[bj][1] = a[1]; lbv[bj][2] = a[2]; lbv[bj][3] = a[3]; lbv[bj][4] = b[0]; lbv[bj][5] = b[1]; lbv[bj][6] = b[2]; lbv[bj][7] = b[3]; }
        }
        if (KIND == 2 && MK_G8) { static_assert(!P64 || !MK_G8 || KIND != 2 || true, "");
#pragma unroll
            for (int ai = 0; ai < 2; ++ai)
#pragma unroll
                for (int m = 0; m < 4; ++m) { unsigned w[4];
#pragma unroll
                    for (int q = 0; q < 4; ++q) { const f32x4 a = acc[ai][q >> 1][m][q & 1]; unsigned t = 0u;
#if MK_PK_EPI
                        const f32x2 s0 = sigm2k((f32x2){a[0], a[1]}, -1.4426950408889634f) * (f32x2){255.f, 255.f}, s1 = sigm2k((f32x2){a[2], a[3]}, -1.4426950408889634f) * (f32x2){255.f, 255.f};
                        const float sv[4] = {s0.x, s0.y, s1.x, s1.y};
#pragma unroll
                        for (int j = 0; j < 4; ++j) t = __builtin_amdgcn_cvt_pk_u8_f32(fmaxf(__builtin_rintf(sv[j]), 1.f), (unsigned)j, t);
#else
#pragma unroll
                        for (int j = 0; j < 4; ++j) t = __builtin_amdgcn_cvt_pk_u8_f32(fmaxf(__builtin_rintf(fsigm(a[j]) * 255.f), 1.f), (unsigned)j, t);
#endif
                        w[q] = t; }
                    *(u32x4*)(g8 + (size_t)(row0 + ai * 128 + m * 16) * 4096 + (col0 - Z_MGA)) = (u32x4){w[0], w[1], w[2], w[3]}; }
            return; }
#pragma unroll
        for (int ai = 0; ai < 2; ++ai)
#pragma unroll
            for (int m = 0; m < 4; ++m) { bf16_t* rowp = Z + (size_t)(row0 + ai * 128 + m * 16) * NZ + col0;
#pragma unroll
                for (int bj = 0; bj < 2; ++bj) { float v[8];
#pragma unroll
                    for (int j = 0; j < 4; ++j) { v[j] = acc[ai][bj][m][0][j]; v[4 + j] = acc[ai][bj][m][1][j]; }
#if MK_PK_EPI
#pragma unroll
                    for (int j = 0; j < 8; j += 2) { f32x2 x = {v[j], v[j + 1]};
                        if (KIND == 0) x = x * (f32x2){sc, sc};
                        else if (KIND == 1) x = (x * (f32x2){sc, sc}) * sigm2k(x, -1.4426950408889634f);
                        else if (KIND == 2) x = sigm2k(x, -1.4426950408889634f);
                        else { const f32x2 l = {lbv[bj][j], lbv[bj][j + 1]}; const f32x2 t = l + ((f32x2){1.f, 1.f} - l) * sigm2k(x, -1.4426950408889634f);
                            x = (f32x2){__builtin_amdgcn_logf(t.x), __builtin_amdgcn_logf(t.y)} * (f32x2){0.6931471805599453f, 0.6931471805599453f}; }
                        v[j] = x.x; v[j + 1] = x.y; }
#else
#pragma unroll
                    for (int j = 0; j < 8; ++j) {
                        if (KIND == 0) v[j] *= sc;
                        else if (KIND == 1) v[j] = v[j] * fsigm(v[j]) * sc;
                        else if (KIND == 2) v[j] = fsigm(v[j]);
                        else { const float l = lbv[bj][j]; v[j] = __logf(l + (1.f - l) * fsigm(v[j])); }
                    }
#endif
                    u32x4 w; w.x = cvt_pk_bf16(v[0], v[1]); w.y = cvt_pk_bf16(v[2], v[3]); w.z = cvt_pk_bf16(v[4], v[5]); w.w = cvt_pk_bf16(v[6], v[7]);
                    *(u32x4*)(rowp + bj * BJS) = w; } }
    }
    __device__ __forceinline__ bool operator()(f32x4 (&acc)[2][2][4][2], const pg8::Unit& u, int wr, int wc, int fr, int fq, const Pre&) const {
        const int colt = coloff + u.pn * 256; int kind; float sc = 1.f;
        if (colt < Z_HFF) { kind = 1; sc = QSCALE; } else if (colt < Z_HI) kind = 3; else if (colt < Z_HOG) kind = 0; else if (colt < Z_GQ) kind = MK_SILU_P3 ? 0 : 1;
        else if (colt < Z_GK) { kind = 0; sc = QSCALE; } else if (colt < Z_GR) kind = 0; else if (colt < Z_MGA) kind = MK_SILU_P3 ? 0 : 1; else kind = 2;
        const int row0 = u.pm * 256 + wr * 64 + fr, col0 = colt + wc * 64 + FQS * fq;
        if (kind == 0) run<0>(acc, row0, col0, sc); else if (kind == 1) run<1>(acc, row0, col0, sc); else if (kind == 2) run<2>(acc, row0, col0, sc); else run<3>(acc, row0, col0, sc);
        return false;
    }
};
typedef EpiInProjT<false> EpiInProj;

struct EpiMerge {
    struct Pre { template <int NAFTER> __device__ __forceinline__ void ready() {} }; __device__ __forceinline__ void preload(Pre&, const pg8::Unit&, int, int) const {}
    ROWS_GU
    static constexpr int VM_MIN = (MK_G8 && MK_FP8_PO) ? 8 : 8;
    const bf16_t* Z; bf16_t* O; const unsigned char* g8;
#if MK_G8 && MK_FP8_PO
    static __device__ __forceinline__ void dec16(const u32x4 g, float (&f)[16]) {
        const unsigned w[4] = {g.x, g.y, g.z, g.w};
#pragma unroll
        for (int q = 0; q < 4; ++q)
#pragma unroll
            for (int j = 0; j < 4; ++j) f[4 * q + j] = (float)((w[q] >> (8 * j)) & 0xffu) * (1.f / 255.f); }
    __device__ __forceinline__ void seg0(f32x4 (&acc)[2][2][4][2], int row0, int col0) const {
#pragma unroll
        for (int ai = 0; ai < 2; ++ai)
#pragma unroll
            for (int mp = 0; mp < 2; ++mp) { u32x4 ga[2], gb[2];
#pragma unroll
                for (int mm = 0; mm < 2; ++mm) { const unsigned char* gp = g8 + (size_t)(row0 + ai * 128 + (2 * mp + mm) * 16) * 4096 + col0; ga[mm] = *(const u32x4*)gp; gb[mm] = *(const u32x4*)(gp + 2048); }
#pragma unroll
                for (int mm = 0; mm < 2; ++mm) { const int m = 2 * mp + mm; float sa[16], sb[16]; dec16(ga[mm], sa); dec16(gb[mm], sb);
#pragma unroll
                    for (int bj = 0; bj < 2; ++bj)
#pragma unroll
                        for (int n = 0; n < 2; ++n)
#pragma unroll
                            for (int j = 0; j < 4; ++j) acc[ai][bj][m][n][j] *= sa[8 * bj + 4 * n + j] * __builtin_amdgcn_rcpf(sb[8 * bj + 4 * n + j]); } } }
    __device__ __forceinline__ void seg1(f32x4 (&acc)[2][2][4][2], int row0, int col0) const {
#pragma unroll
        for (int ai = 0; ai < 2; ++ai) { u32x4 gb[4];
#pragma unroll
            for (int m = 0; m < 4; ++m) gb[m] = *(const u32x4*)(g8 + (size_t)(row0 + ai * 128 + m * 16) * 4096 + 2048 + col0);
#pragma unroll
            for (int m = 0; m < 4; ++m) { float sb[16]; dec16(gb[m], sb); unsigned w[4];
#pragma unroll
                for (int q = 0; q < 4; ++q) { const f32x4 a = acc[ai][q >> 1][m][q & 1];
                    const unsigned t = __builtin_amdgcn_cvt_pk_fp8_f32(a[0] * sb[4 * q], a[1] * sb[4 * q + 1], 0u, false); w[q] = __builtin_amdgcn_cvt_pk_fp8_f32(a[2] * sb[4 * q + 2], a[3] * sb[4 * q + 3], t, true); }
                *(u32x4*)((unsigned char*)O + (size_t)(row0 + ai * 128 + m * 16) * D + col0) = (u32x4){w[0], w[1], w[2], w[3]}; } } }
    __device__ __forceinline__ bool operator()(f32x4 (&acc)[2][2][4][2], const pg8::Unit& u, int wr, int wc, int fr, int fq, const Pre&) const {
        const int row0 = u.pm * 256 + wr * 64 + fr, col0 = u.pn * 256 + wc * 64 + 16 * fq; const bool first = (u.aux == 0);
        if (first) seg0(acc, row0, col0); else seg1(acc, row0, col0);
        return first;
    }
#else
    __device__ __forceinline__ bool operator()(f32x4 (&acc)[2][2][4][2], const pg8::Unit& u, int wr, int wc, int fr, int fq) const {
        const int row0 = u.pm * 256 + wr * 64 + fr, col0 = u.pn * 256 + wc * 64 + 16 * fq; const bool first = (u.aux == 0);
#pragma unroll
        for (int ai = 0; ai < 2; ++ai)
#pragma unroll
            for (int m = 0; m < 4; ++m) { const size_t r = (size_t)(row0 + ai * 128 + m * 16);
#pragma unroll
                for (int bj = 0; bj < 2; ++bj) {
#if MK_G8
                    const u32x2 gb = *(const u32x2*)(g8 + r * 4096 + 2048 + col0 + bj * 8); float sb[8];
#pragma unroll
                    for (int j = 0; j < 4; ++j) { sb[j] = (float)((gb.x >> (8 * j)) & 0xffu) * (1.f / 255.f); sb[4 + j] = (float)((gb.y >> (8 * j)) & 0xffu) * (1.f / 255.f); }
#else
                    const u32x4 gb = *(const u32x4*)(Z + r * NZ + Z_MGB + col0 + bj * 8);
                    float sb[8] = {bf_lo(gb.x), bf_hi(gb.x), bf_lo(gb.y), bf_hi(gb.y), bf_lo(gb.z), bf_hi(gb.z), bf_lo(gb.w), bf_hi(gb.w)};
#endif
                    if (first) {
#if MK_G8
                        const u32x2 ga = *(const u32x2*)(g8 + r * 4096 + col0 + bj * 8); float sa[8];
#pragma unroll
                        for (int j = 0; j < 4; ++j) { sa[j] = (float)((ga.x >> (8 * j)) & 0xffu) * (1.f / 255.f); sa[4 + j] = (float)((ga.y >> (8 * j)) & 0xffu) * (1.f / 255.f); }
#else
                        const u32x4 ga = *(const u32x4*)(Z + r * NZ + Z_MGA + col0 + bj * 8);
                        float sa[8] = {bf_lo(ga.x), bf_hi(ga.x), bf_lo(ga.y), bf_hi(ga.y), bf_lo(ga.z), bf_hi(ga.z), bf_lo(ga.w), bf_hi(ga.w)};
#endif
#pragma unroll
                        for (int j = 0; j < 4; ++j) { acc[ai][bj][m][0][j] *= sa[j] * __builtin_amdgcn_rcpf(fmaxf(sb[j], 1e-30f)); acc[ai][bj][m][1][j] *= sa[4 + j] * __builtin_amdgcn_rcpf(fmaxf(sb[4 + j], 1e-30f)); }
                    } else {
                        float v[8];
#pragma unroll
                        for (int j = 0; j < 4; ++j) { v[j] = acc[ai][bj][m][0][j] * sb[j]; v[4 + j] = acc[ai][bj][m][1][j] * sb[4 + j]; }
#if MK_FP8_PO
                        unsigned w0 = __builtin_amdgcn_cvt_pk_fp8_f32(v[0], v[1], 0u, false); w0 = __builtin_amdgcn_cvt_pk_fp8_f32(v[2], v[3], w0, true);
                        unsigned w1 = __builtin_amdgcn_cvt_pk_fp8_f32(v[4], v[5], 0u, false); w1 = __builtin_amdgcn_cvt_pk_fp8_f32(v[6], v[7], w1, true);
                        *(u32x2*)((unsigned char*)O + r * D + col0 + bj * 8) = (u32x2){w0, w1};
#else
                        u32x4 w; w.x = cvt_pk_bf16(v[0], v[1]); w.y = cvt_pk_bf16(v[2], v[3]); w.z = cvt_pk_bf16(v[4], v[5]); w.w = cvt_pk_bf16(v[6], v[7]);
                        *(u32x4*)(O + r * D + col0 + bj * 8) = w;
#endif
                    } } }
        return first;
    }
#endif
};
#ifndef MK_H1_BF16
#define MK_H1_BF16 0
#endif
struct EpiMix {
    struct Pre { template <int NAFTER> __device__ __forceinline__ void ready() {} }; __device__ __forceinline__ void preload(Pre&, const pg8::Unit&, int, int) const {}
#if MK_ROWS64
    ROWS_64
    static constexpr int BJS = 32, FQS = 8;
#else
    ROWS_GU
    static constexpr int BJS = 8, FQS = 16;
#endif
    static constexpr int VM_MIN = 16;
    bf16_t* out; const float* x;
#if MK_H1_BF16
    __device__ __forceinline__ void ldx(f32x4 (&xv)[2][2][2], int row0, int col0, int c) const {
#pragma unroll
        for (int mm = 0; mm < 2; ++mm) { const float* xp = x + (size_t)(row0 + (c >> 1) * 128 + (2 * (c & 1) + mm) * 16) * D + col0;
#pragma unroll
            for (int bj = 0; bj < 2; ++bj) { xv[mm][bj][0] = __builtin_nontemporal_load((const f32x4*)(xp + bj * BJS)); xv[mm][bj][1] = __builtin_nontemporal_load((const f32x4*)(xp + bj * BJS + 4)); } } }
#endif
    __device__ __forceinline__ void st(f32x4 (&acc)[2][2][4][2], f32x4 (&xv)[2][2][2], int row0, int col0, int c) const {
#pragma unroll
        for (int mm = 0; mm < 2; ++mm) { const int ai = c >> 1, m = 2 * (c & 1) + mm; bf16_t* rowp = out + (size_t)(row0 + ai * 128 + m * 16) * D + col0;
#pragma unroll
            for (int bj = 0; bj < 2; ++bj) { f32x4 v0 = acc[ai][bj][m][0], v1 = acc[ai][bj][m][1];
#if MK_H1_BF16
                v0 += xv[mm][bj][0]; v1 += xv[mm][bj][1];
#endif
                *(u32x4*)(rowp + bj * BJS) = (u32x4){cvt_pk_bf16(v0[0], v0[1]), cvt_pk_bf16(v0[2], v0[3]), cvt_pk_bf16(v1[0], v1[1]), cvt_pk_bf16(v1[2], v1[3])}; } } }
    __device__ __forceinline__ bool operator()(f32x4 (&acc)[2][2][4][2], const pg8::Unit& u, int wr, int wc, int fr, int fq, const Pre&) const {
        const int row0 = u.pm * 256 + wr * 64 + fr, col0 = u.pn * 256 + wc * 64 + FQS * fq;
        f32x4 xa[2][2][2], xb[2][2][2];
#if MK_H1_BF16
        ldx(xa, row0, col0, 0); ldx(xb, row0, col0, 1);
        st(acc, xa, row0, col0, 0); ldx(xa, row0, col0, 2);
        st(acc, xb, row0, col0, 1); ldx(xb, row0, col0, 3);
        st(acc, xa, row0, col0, 2); st(acc, xb, row0, col0, 3);
#else
#pragma unroll
        for (int c = 0; c < 4; ++c) st(acc, xa, row0, col0, c);
#endif
        return false;
    }
};
struct EpiGU {
    ROWS_GU
    static constexpr int VM_MIN = 8;
    bf16_t* act; const float* bias;
    struct Pre { f32x4 bv[2][2];
        template <int NAFTER> __device__ __forceinline__ void ready() { asm volatile("s_waitcnt vmcnt(%4)" : "+v"(bv[0][0]), "+v"(bv[0][1]), "+v"(bv[1][0]), "+v"(bv[1][1]) : "n"(NAFTER) : "memory"); } };
    __device__ __forceinline__ void preload(Pre& p, const pg8::Unit& u, int wc, int fq) const {
        const float* bp = bias + (size_t)u.aux * 4096 + u.pn * 256; const unsigned vo = (unsigned)(wc * 64 + 16 * fq) * 4u;
#pragma unroll
        for (int bj = 0; bj < 2; ++bj)
#pragma unroll
            for (int n = 0; n < 2; ++n) asm volatile("global_load_dwordx4 %0, %1, %2" : "=v"(p.bv[bj][n]) : "v"(vo + (unsigned)(8 * bj + 4 * n) * 4u), "s"(bp) : "memory"); }
    __device__ __forceinline__ bool operator()(f32x4 (&acc)[2][2][4][2], const pg8::Unit& u, int wr, int wc, int fr, int fq, const Pre& pre) const {
        const int row0 = u.r0 + wr * 64 + fr, col0 = u.pn * 256 + wc * 64 + 16 * fq;
        const f32x4 (&bv)[2][2] = pre.bv;
#pragma unroll
        for (int ai = 0; ai < 2; ++ai)
#pragma unroll
            for (int m = 0; m < 4; ++m) { float o[8];
#pragma unroll
                for (int bj = 0; bj < 2; ++bj)
#pragma unroll
                    for (int n = 0; n < 2; ++n) { const f32x4 v = acc[ai][bj][m][n] + bv[bj][n];
#if MK_PK_EPI
                        const f32x2 gate = {fminf(v[0], 7.f), fminf(v[2], 7.f)}, up = {fminf(fmaxf(v[1], -7.f), 7.f), fminf(fmaxf(v[3], -7.f), 7.f)};
                        const f32x2 r = (up + (f32x2){1.f, 1.f}) * (gate * sigm2k(gate, -1.702f * 1.4426950408889634f)); o[4 * bj + 2 * n] = r.x; o[4 * bj + 2 * n + 1] = r.y; }
#else
#pragma unroll
                        for (int p = 0; p < 2; ++p) { const float gate = fminf(v[2 * p], 7.f); const float up = fminf(fmaxf(v[2 * p + 1], -7.f), 7.f); o[4 * bj + 2 * n + p] = (up + 1.f) * (gate * fsigm(1.702f * gate)); } }
#endif
                const size_t r = (size_t)(row0 + ai * 128 + m * 16);
#if MK_FP8
                unsigned w0 = __builtin_amdgcn_cvt_pk_fp8_f32(o[0], o[1], 0u, false); w0 = __builtin_amdgcn_cvt_pk_fp8_f32(o[2], o[3], w0, true);
                unsigned w1 = __builtin_amdgcn_cvt_pk_fp8_f32(o[4], o[5], 0u, false); w1 = __builtin_amdgcn_cvt_pk_fp8_f32(o[6], o[7], w1, true);
                *(u32x2*)((unsigned char*)act + r * D + (col0 >> 1)) = (u32x2){w0, w1};
#else
                *(u32x4*)(act + r * D + (col0 >> 1)) = (u32x4){cvt_pk_bf16(o[0], o[1]), cvt_pk_bf16(o[2], o[3]), cvt_pk_bf16(o[4], o[5]), cvt_pk_bf16(o[6], o[7])};
#endif
            }
        return false;
    }
};
struct EpiDown {
    struct Pre { template <int NAFTER> __device__ __forceinline__ void ready() {} }; __device__ __forceinline__ void preload(Pre&, const pg8::Unit&, int, int) const {}
    ROWS_GU
    static constexpr int VM_MIN = MK_TAIL_SPLIT ? 4 : 8;
    unsigned char* yp; const float* bias; const float* roww;
    __device__ __forceinline__ bool operator()(f32x4 (&acc)[2][2][4][2], const pg8::Unit& u, int wr, int wc, int fr, int fq, const Pre&) const {
        const int ro = (MK_TAIL_SPLIT && u.half == 2) ? 128 : 0;
        const int rl0 = wr * 64 + fr + ro, col0 = u.pn * 256 + wc * 64 + 16 * fq; const float* bp = bias + (size_t)u.aux * D + col0; const float* wp = roww + (size_t)u.aux * NTOK + u.r0;
        f32x4 bv[2][2];
#pragma unroll
        for (int bj = 0; bj < 2; ++bj)
#pragma unroll
            for (int n = 0; n < 2; ++n) bv[bj][n] = *(const f32x4*)(bp + bj * 8 + 4 * n);
        float wv[2][4];
#pragma unroll
        for (int ai = 0; ai < 2; ++ai)
#pragma unroll
            for (int m = 0; m < 4; ++m) wv[ai][m] = wp[(rl0 + ai * 128 + m * 16) & 0xffffff];
        asm volatile("" ::: "memory");
#pragma unroll
        for (int ai = 0; ai < 2; ++ai) { if (MK_TAIL_SPLIT && ai == 1 && u.half != 0) break;
#pragma unroll
            for (int m = 0; m < 4; ++m) { const int rl = rl0 + ai * 128 + m * 16; const float w = wv[ai][m] * 16.f; unsigned o[4];
#pragma unroll
                for (int bj = 0; bj < 2; ++bj)
#pragma unroll
                    for (int n = 0; n < 2; ++n) { const f32x4 v = (acc[ai][bj][m][n] + bv[bj][n]) * w;
                        unsigned t = __builtin_amdgcn_cvt_pk_fp8_f32(v[0], v[1], 0u, false); o[2 * bj + n] = __builtin_amdgcn_cvt_pk_fp8_f32(v[2], v[3], t, true); }
                *(u32x4*)(yp + (size_t)(u.pm * 256 + rl) * D + col0) = (u32x4){o[0], o[1], o[2], o[3]}; } }
        return false;
    }
};

#ifndef MK_KF_PROBE
#define MK_KF_PROBE 0
#endif
template <int NCOL>
struct KFillW {
    static constexpr bool ON = true; static constexpr int NL = 4, NS = 4, NB = NCOL / 32, PER_E = 64 * NB, ITEMS = NE * PER_E;
    const float* W; unsigned char* WT; int nwv, gw, lane, fbase; unsigned ldsdead = 0;
    __device__ __forceinline__ void locate(int fi, size_t& src, size_t& dst) const {
        int it = (fbase + fi) * nwv + gw; it = it < ITEMS ? it : ITEMS - 1; if (MK_KF_PROBE == 1 || MK_KF_PROBE == 4 || MK_KF_PROBE == 6) it = gw;
        const int e = __builtin_amdgcn_readfirstlane(it / PER_E), q = __builtin_amdgcn_readfirstlane(it % PER_E), kb = q / NB, nb = q % NB;
        src = ((size_t)e * D * NCOL + (size_t)(kb * 32) * NCOL + (size_t)nb * 32) * 4; dst = (size_t)e * NCOL * D + (size_t)(nb * 32) * D + kb * 32; }
    __device__ __forceinline__ void issue(f32x4 (&kf)[4], int fi) const {
        size_t src, dst; locate(fi, src, dst); const char* ub = (const char*)W + src; const unsigned vo = (unsigned)((4 * (lane >> 3)) * NCOL + 4 * (lane & 7)) * 4u;
        if ((MK_KF_PROBE == 6 || MK_KF_PROBE == 7) && ldsdead != 0u) {
            const unsigned m0v = ldsdead; unsigned keep_;
#pragma unroll
            for (int i = 0; i < 4; ++i) asm volatile("s_mov_b32 %0, m0\n\ts_mov_b32 m0, %3\n\ts_nop 0\n\tglobal_load_lds_dwordx4 %1, %2\n\ts_mov_b32 m0, %0" : "=&s"(keep_) : "v"(vo), "s"(ub + (size_t)i * (NCOL * 4)), "s"(m0v) : "memory", "scc");
            return; }
#pragma unroll
        for (int i = 0; i < 4; ++i) asm volatile("global_load_dwordx4 %0, %1, %2 nt" : "=v"(kf[i]) : "v"(vo), "s"(ub + (size_t)i * (NCOL * 4)) : "memory"); }
    __device__ __forceinline__ void consume(f32x4 (&kf)[4], int fi) const {
        size_t src, dst; locate(fi, src, dst); unsigned char* ud = WT + dst; const unsigned vo = (unsigned)((4 * (lane & 7)) * D + 4 * (lane >> 3));
        if (MK_KF_PROBE == 3 || MK_KF_PROBE == 4 || MK_KF_PROBE == 6 || MK_KF_PROBE == 7) { asm volatile("" :: "v"(kf[0]), "v"(kf[1]), "v"(kf[2]), "v"(kf[3])); return; }
#pragma unroll
        for (int j = 0; j < 4; ++j) { const unsigned t = __builtin_amdgcn_cvt_pk_fp8_f32(kf[0][j] * 256.f, kf[1][j] * 256.f, 0u, false);
            *(unsigned*)(ud + vo + (size_t)j * D) = __builtin_amdgcn_cvt_pk_fp8_f32(kf[2][j] * 256.f, kf[3][j] * 256.f, t, true); } }
    __device__ __forceinline__ void finish(int fi, int fend = 1 << 30) const {
        for (; fi < fend && (fbase + fi) * nwv + gw < ITEMS; ++fi) { f32x4 kf[4]; issue(kf, fi); asm volatile("s_waitcnt vmcnt(0)" : "+v"(kf[0]), "+v"(kf[1]), "+v"(kf[2]), "+v"(kf[3]) :: "memory"); consume(kf, fi); } }
};
constexpr int KDN_P1 = 32;
#ifndef MK_DN_FILL
#define MK_DN_FILL (MK_GU_KFILL ? 0 : 1)
#endif
constexpr int DNF_NL = 8, DNF_KB = 8 * DNF_NL, DNF_ITEMS = NE * (D / DNF_KB) * 64;
#ifndef MK_DN_FILL_P7
#define MK_DN_FILL_P7 1
#endif
constexpr int DNF_UNITS = MK_DN_FILL_P7 ? 32 : 18;
struct DownFill {
    static constexpr bool ON = true; static constexpr int NL = DNF_NL, NS = 4;
    const float* W; unsigned char* WT; int ubase, nwv, gw, lane;
    __device__ __forceinline__ void locate(int ui, size_t& src, size_t& dst) const {
        int sl = ubase + ui; sl = sl < DNF_UNITS ? sl : DNF_UNITS - 1;
        int it = sl * nwv + gw; it = it < DNF_ITEMS ? it : DNF_ITEMS - 1;
        constexpr int PER_E = (D / DNF_KB) * 64; const int e = __builtin_amdgcn_readfirstlane(it / PER_E), q = __builtin_amdgcn_readfirstlane(it % PER_E), kb = q >> 6, nb = q & 63;
        src = ((size_t)e * D * D + (size_t)(kb * DNF_KB) * D + (size_t)nb * 32) * 4; dst = (size_t)e * D * D + (size_t)(nb * 32) * D + kb * DNF_KB; }
    template <int LO, int HI> __device__ __forceinline__ void issue_part(f32x4 (&ff)[DNF_NL], int ui) const {
        size_t src, dst; locate(ui, src, dst); const char* ub = (const char*)W + src; const unsigned vo = (unsigned)((DNF_NL * (lane >> 3)) * D + 4 * (lane & 7)) * 4u;
#pragma unroll
        for (int i = LO; i < HI; ++i) asm volatile("global_load_dwordx4 %0, %1, %2 nt" : "=v"(ff[i]) : "v"(vo + (unsigned)i * (D * 4u)), "s"(ub) : "memory"); }
    __device__ __forceinline__ void issue(f32x4 (&ff)[DNF_NL], int ui) const {
        size_t src, dst; locate(ui, src, dst); const char* ub = (const char*)W + src; const unsigned vo = (unsigned)((DNF_NL * (lane >> 3)) * D + 4 * (lane & 7)) * 4u;
#if MK_FILL_ASM
#pragma unroll
        for (int i = 0; i < DNF_NL; ++i) asm volatile("global_load_dwordx4 %0, %1, %2 nt" : "=v"(ff[i]) : "v"(vo + (unsigned)i * (D * 4u)), "s"(ub) : "memory");
#else
#pragma unroll
        for (int i = 0; i < DNF_NL; ++i) ff[i] = __builtin_nontemporal_load((const f32x4*)(ub + (size_t)i * (D * 4) + vo));
        asm volatile("" ::: "memory");
#endif
    }
    template <int NAFTER> __device__ __forceinline__ void consume_w(f32x4 (&ff)[DNF_NL], int ui) const {
        static_assert(DNF_NL == 8, "tie");
        asm volatile("s_waitcnt vmcnt(%8)" : "+v"(ff[0]), "+v"(ff[1]), "+v"(ff[2]), "+v"(ff[3]), "+v"(ff[4]), "+v"(ff[5]), "+v"(ff[6]), "+v"(ff[7]) : "n"(NAFTER) : "memory");
        consume(ff, ui); }
    __device__ __forceinline__ void consume(f32x4 (&ff)[DNF_NL], int ui) const {
        size_t src, dst; locate(ui, src, dst); unsigned char* ud = WT + dst; const unsigned vo = (unsigned)((4 * (lane & 7)) * D + DNF_NL * (lane >> 3));
#pragma unroll
        for (int j = 0; j < 4; ++j) { unsigned w[DNF_NL / 4];
#pragma unroll
            for (int d = 0; d < DNF_NL / 4; ++d) { const unsigned t = __builtin_amdgcn_cvt_pk_fp8_f32(ff[4 * d][j] * 256.f, ff[4 * d + 1][j] * 256.f, 0u, false); w[d] = __builtin_amdgcn_cvt_pk_fp8_f32(ff[4 * d + 2][j] * 256.f, ff[4 * d + 3][j] * 256.f, t, true); }
            if constexpr (DNF_NL == 16) *(u32x4*)(ud + vo + (size_t)j * D) = (u32x4){w[0], w[1], w[2], w[3]}; else *(u32x2*)(ud + vo + (size_t)j * D) = (u32x2){w[0], w[1]}; } }
};

#define LDS_WAIT() asm volatile("s_waitcnt lgkmcnt(0)" ::: "memory")
#define VM_WAIT() asm volatile("s_waitcnt vmcnt(0)" ::: "memory")

__device__ __forceinline__ void p0_transpose_item(const float* W, size_t ldw, bf16_t* WT, size_t ldt, int k0, int n0s, int n0d, LAS float* scr, int lane, const float* gk = nullptr) {
#pragma unroll 8
    for (int i = 0; i < 32; ++i) { const int kk = 2 * i + (lane >> 5); scr[kk * 33 + (lane & 31)] = __builtin_nontemporal_load(W + (size_t)(k0 + kk) * ldw + n0s + (lane & 31)); }
    LDS_WAIT(); asm volatile("" ::: "memory");
    const int c = lane & 7;
#pragma unroll
    for (int j = 0; j < 4; ++j) { const int n = (lane >> 3) + 8 * j; const LAS float* s = scr + (8 * c) * 33 + n;
        u32x4 o;
        if (gk != nullptr) { const f32x4 ga = *(const f32x4*)(gk + k0 + 8 * c), gb = *(const f32x4*)(gk + k0 + 8 * c + 4);
            o.x = pk2(s[0 * 33] * ga.x, s[1 * 33] * ga.y); o.y = pk2(s[2 * 33] * ga.z, s[3 * 33] * ga.w); o.z = pk2(s[4 * 33] * gb.x, s[5 * 33] * gb.y); o.w = pk2(s[6 * 33] * gb.z, s[7 * 33] * gb.w); }
        else { o.x = pk2(s[0 * 33], s[1 * 33]); o.y = pk2(s[2 * 33], s[3 * 33]); o.z = pk2(s[4 * 33], s[5 * 33]); o.w = pk2(s[6 * 33], s[7 * 33]); }
        *(u32x4*)(WT + (size_t)(n0d + n) * ldt + k0 + 8 * c) = o; }
    LDS_WAIT(); asm volatile("" ::: "memory");
}
__device__ __forceinline__ void p0_transpose_item_f8(const float* W, size_t ldw, unsigned char* WT, size_t ldt, int k0, int n0s, int n0d, LAS float* scr, int lane, const float* gk = nullptr) {
#pragma unroll 8
    for (int i = 0; i < 32; ++i) { const int kk = 2 * i + (lane >> 5); scr[kk * 33 + (lane & 31)] = __builtin_nontemporal_load(W + (size_t)(k0 + kk) * ldw + n0s + (lane & 31)); }
    LDS_WAIT(); asm volatile("" ::: "memory");
    const int c = lane & 7;
#pragma unroll
    for (int j = 0; j < 4; ++j) { const int n = (lane >> 3) + 8 * j; const LAS float* s = scr + (8 * c) * 33 + n;
        f32x4 ga = {256.f, 256.f, 256.f, 256.f}, gb = ga;
        if (gk != nullptr) { ga = *(const f32x4*)(gk + k0 + 8 * c) * 256.f; gb = *(const f32x4*)(gk + k0 + 8 * c + 4) * 256.f; }
        unsigned w0 = __builtin_amdgcn_cvt_pk_fp8_f32(s[0 * 33] * ga.x, s[1 * 33] * ga.y, 0u, false); w0 = __builtin_amdgcn_cvt_pk_fp8_f32(s[2 * 33] * ga.z, s[3 * 33] * ga.w, w0, true);
        unsigned w1 = __builtin_amdgcn_cvt_pk_fp8_f32(s[4 * 33] * gb.x, s[5 * 33] * gb.y, 0u, false); w1 = __builtin_amdgcn_cvt_pk_fp8_f32(s[6 * 33] * gb.z, s[7 * 33] * gb.w, w1, true);
        *(u32x2*)(WT + (size_t)(n0d + n) * ldt + k0 + 8 * c) = (u32x2){w0, w1}; }
    LDS_WAIT(); asm volatile("" ::: "memory");
}
__device__ __forceinline__ void p0_transpose_item_f8w(const float* W, size_t ldw, unsigned char* WT, size_t ldt, int k0, int n0, LAS float* scr, int lane) {
#pragma unroll 8
    for (int i = 0; i < 32; ++i) scr[i * 65 + lane] = __builtin_nontemporal_load(W + (size_t)(k0 + i) * ldw + n0 + lane);
    LDS_WAIT(); asm volatile("" ::: "memory");
    const int c = lane & 3;
#pragma unroll
    for (int j = 0; j < 4; ++j) { const int n = (lane >> 2) + 16 * j; const LAS float* s = scr + (8 * c) * 65 + n;
        unsigned w0 = __builtin_amdgcn_cvt_pk_fp8_f32(s[0 * 65] * 256.f, s[1 * 65] * 256.f, 0u, false); w0 = __builtin_amdgcn_cvt_pk_fp8_f32(s[2 * 65] * 256.f, s[3 * 65] * 256.f, w0, true);
        unsigned w1 = __builtin_amdgcn_cvt_pk_fp8_f32(s[4 * 65] * 256.f, s[5 * 65] * 256.f, 0u, false); w1 = __builtin_amdgcn_cvt_pk_fp8_f32(s[6 * 65] * 256.f, s[7 * 65] * 256.f, w1, true);
        *(u32x2*)(WT + (size_t)(n0 + n) * ldt + k0 + 8 * c) = (u32x2){w0, w1}; }
    LDS_WAIT(); asm volatile("" ::: "memory");
}
__device__ __forceinline__ void rms_row_to_bf16(const float* xrow, const float* g, bf16_t* orow, unsigned* orow8, int lane, float* rr_out = nullptr) {
    const f32x4* xr = (const f32x4*)xrow + lane; const f32x4* gr = (const f32x4*)g + lane;
    f32x4 v[8]; float s = 0.f;
#pragma unroll
    for (int j = 0; j < 8; ++j) { v[j] = __builtin_nontemporal_load(xr + 64 * j); s += (v[j].x * v[j].x + v[j].y * v[j].y) + (v[j].z * v[j].z + v[j].w * v[j].w); }
    const float r = rsqrtf(wave_sum(s) * (1.f / D) + RMS_EPS);
    if (rr_out != nullptr && lane == 0) *rr_out = __builtin_amdgcn_rcpf(r);
    u32x2* o8 = (u32x2*)orow + lane;
#pragma unroll
    for (int j = 0; j < 8; ++j) { const f32x4 gg = MK_P6_XN ? (f32x4){1.f, 1.f, 1.f, 1.f} : gr[64 * j]; const f32x4 y = {v[j].x * r * gg.x, v[j].y * r * gg.y, v[j].z * r * gg.z, v[j].w * r * gg.w};
        u32x2 w; w.x = pk2(y.x, y.y); w.y = pk2(y.z, y.w); o8[64 * j] = w;
#if MK_FP8_MG
        unsigned w8 = __builtin_amdgcn_cvt_pk_fp8_f32(y.x, y.y, 0u, false); w8 = __builtin_amdgcn_cvt_pk_fp8_f32(y.z, y.w, w8, true); orow8[lane + 64 * j] = w8;
#endif
    }
}
#ifndef MK_P0_LRSPLIT
#define MK_P0_LRSPLIT 1
#endif
__device__ __forceinline__ void p0_prologue(Frame& F) {
    LAS float* scr = (LAS float*)(F.lds + F.wave * 16384);
    const int gw = F.vcu * NWAVES + F.wave, NGW = F.G * NWAVES;
    { const int gt = gw * 64 + F.lane, NGT = NGW * 64;
      for (int i = gt; i < 2048; i += NGT) { const int d = i >> 10, c = i & 1023; const float a = F.lb_logits[(d * 2 + 0) * 1024 + c], b = F.lb_logits[(d * 2 + 1) * 1024 + c];
          const float m = fmaxf(a, b), ea = __expf(a - m), eb = __expf(b - m); WSP(float, WS_LB)[i] = ea / (ea + eb); }
      for (int i = gt; i < 2 * 512 * 32; i += NGT) { const int r = i & 31, c = (i >> 5) & 511, d = i >> 14; WSP(bf16_t, WS_W2T)[i] = r < 16 ? (bf16_t)f2bf(F.gla_w2[(d * 16 + r) * 512 + c]) : (bf16_t)0; } }
#if MK_P0_LRSPLIT
    for (int k = gw; k < D; k += NGW) if (F.lane < 32) WSP(bf16_t, WS_WLRT)[(size_t)F.lane * D + k] = (bf16_t)f2bf(F.w_in[(size_t)k * DIN + 8192 + F.lane] * (MK_P6_XN ? F.norm1_g[k] : 1.f));
#endif
    for (int m = gw; m < NTOK; m += NGW) rms_row_to_bf16(F.x + (size_t)m * D, F.norm1_g, WSP(bf16_t, WS_XN) + (size_t)m * D, (unsigned*)(F.ws + WS_XN8 + (size_t)m * D), F.lane, MK_P6_XN ? WSP(float, WS_RR) + m : nullptr);
    constexpr int I_IN = 32 * (MK_P0_LRSPLIT ? 384 : 385), I_PA = 16 * 64, I_OUT = 32 * 64, I_GU = (MK_FP8 && MK_GU_KFILL && !MK_KF_PROBE) ? 0 : (MK_FP8 && MK_GU_IN_P2 && !MK_GU_PROBE) ? MK_GU_P2_SKIP * 2048 : (MK_FP8 ? 16 : 32) * 32 * 128, I_DN = (MK_FP8 && (MK_DN_FILL || (MK_GU_KFILL && !MK_KF_PROBE))) ? 0 : (MK_FP8 ? 16 : 32) * 32 * 64;
    constexpr int DN_FIRST = DNF_UNITS * 256 * NWAVES;
    constexpr int NITEMS = I_IN + 2 * I_PA + I_OUT + I_GU + I_DN;
    for (int it = gw; it < NITEMS; it += NGW) {
        int r = it;
#if MK_P0_LRSPLIT
        if (r < I_IN) { const int kb = r / 384, nbq = r % 384, nb = nbq < 256 ? nbq : nbq + 1;
#else
        if (r < I_IN) { const int kb = r / 385, nb = r % 385;
#endif
#if MK_FP8_MG && MK_FP8_VG
            if (nb == 256) p0_transpose_item(F.w_in, DIN, WSP(bf16_t, WS_WLRT), D, kb * 64, nb * 32, 0, scr, F.lane, MK_P6_XN ? F.norm1_g : nullptr);
            else { const int zc = (nb < 256 ? nb : nb - 1) * 32;
                if (in_tile_is_f8(zc >> 8)) p0_transpose_item_f8(F.w_in, DIN, WSP(unsigned char, WS_WINT8), D, kb * 64, nb * 32, zc, scr, F.lane, MK_P6_XN ? F.norm1_g : nullptr);
                else p0_transpose_item(F.w_in, DIN, WSP(bf16_t, WS_WINT), D, kb * 64, nb * 32, zc, scr, F.lane, MK_P6_XN ? F.norm1_g : nullptr); }
#elif MK_FP8_MG
            if (nb < 256) p0_transpose_item(F.w_in, DIN, WSP(bf16_t, WS_WINT), D, kb * 64, nb * 32, nb * 32, scr, F.lane, MK_P6_XN ? F.norm1_g : nullptr);
            else if (nb == 256) p0_transpose_item(F.w_in, DIN, WSP(bf16_t, WS_WLRT), D, kb * 64, nb * 32, 0, scr, F.lane, MK_P6_XN ? F.norm1_g : nullptr);
            else p0_transpose_item_f8(F.w_in, DIN, WSP(unsigned char, WS_WINT8), D, kb * 64, nb * 32, (nb - 257) * 32, scr, F.lane, MK_P6_XN ? F.norm1_g : nullptr);
#else
            if (nb < 256) p0_transpose_item(F.w_in, DIN, WSP(bf16_t, WS_WINT), D, kb * 64, nb * 32, nb * 32, scr, F.lane, MK_P6_XN ? F.norm1_g : nullptr);
            else if (nb == 256) p0_transpose_item(F.w_in, DIN, WSP(bf16_t, WS_WLRT), D, kb * 64, nb * 32, 0, scr, F.lane, MK_P6_XN ? F.norm1_g : nullptr);
            else p0_transpose_item(F.w_in, DIN, WSP(bf16_t, WS_WINT), D, kb * 64, nb * 32, (nb - 1) * 32, scr, F.lane, MK_P6_XN ? F.norm1_g : nullptr);
#endif
            continue; } r -= I_IN;
#if MK_FP8_PO
        if (r < I_PA) { p0_transpose_item_f8(F.w_proj_a, D, WSP(unsigned char, WS_WPAT), 1024, (r / 64) * 64, (r % 64) * 32, (r % 64) * 32, scr, F.lane); continue; } r -= I_PA;
        if (r < I_PA) { p0_transpose_item_f8(F.w_proj_b, D, WSP(unsigned char, WS_WPBT), 1024, (r / 64) * 64, (r % 64) * 32, (r % 64) * 32, scr, F.lane); continue; } r -= I_PA;
        if (r < I_OUT) { p0_transpose_item_f8(F.w_out, D, WSP(unsigned char, WS_WOUTT), D, (r / 64) * 64, (r % 64) * 32, (r % 64) * 32, scr, F.lane); continue; } r -= I_OUT;
#else
        if (r < I_PA) { p0_transpose_item(F.w_proj_a, D, WSP(bf16_t, WS_WPAT), 1024, (r / 64) * 64, (r % 64) * 32, (r % 64) * 32, scr, F.lane); continue; } r -= I_PA;
        if (r < I_PA) { p0_transpose_item(F.w_proj_b, D, WSP(bf16_t, WS_WPBT), 1024, (r / 64) * 64, (r % 64) * 32, (r % 64) * 32, scr, F.lane); continue; } r -= I_PA;
        if (r < I_OUT) { p0_transpose_item(F.w_out, D, WSP(bf16_t, WS_WOUTT), D, (r / 64) * 64, (r % 64) * 32, (r % 64) * 32, scr, F.lane); continue; } r -= I_OUT;
#endif
#if MK_FP8
        if (r < I_GU) { const int rr = (MK_FP8 && MK_GU_IN_P2 && !MK_GU_PROBE) ? r + (32 - MK_GU_P2_SKIP) * 2048 : r; const int e = rr / 2048, q = rr % 2048, k0 = (q / 128) * 128, n0 = (q % 128) * 32; const float* Ws = F.w_gate_up + (size_t)e * D * 4096; unsigned char* Wd = WSP(unsigned char, WS_WGUT) + (size_t)e * 4096 * D;
            p0_transpose_item_f8(Ws, 4096, Wd, D, k0, n0, n0, scr, F.lane); p0_transpose_item_f8(Ws, 4096, Wd, D, k0 + 64, n0, n0, scr, F.lane); continue; } r -= I_GU;
        { const int e = r / 1024, q = r % 1024, k0 = (q / 64) * 128, n0 = (q % 64) * 32; const float* Ws = F.w_down + (size_t)e * D * D; unsigned char* Wd = WSP(unsigned char, WS_WDNT) + (size_t)e * D * D;
            p0_transpose_item_f8(Ws, D, Wd, D, k0, n0, n0, scr, F.lane); p0_transpose_item_f8(Ws, D, Wd, D, k0 + 64, n0, n0, scr, F.lane); }
#else
        if (r < I_GU) { const int e = r / 4096, q = r % 4096; p0_transpose_item(F.w_gate_up + (size_t)e * D * 4096, 4096, WSP(bf16_t, WS_WGUT) + (size_t)e * 4096 * D, D, (q / 128) * 64, (q % 128) * 32, (q % 128) * 32, scr, F.lane); continue; } r -= I_GU;
        { const int e = r / 2048, q = r % 2048; p0_transpose_item(F.w_down + (size_t)e * D * D, D, WSP(bf16_t, WS_WDNT) + (size_t)e * D * D, D, (q / 64) * 64, (q % 64) * 32, (q % 64) * 32, scr, F.lane); }
#endif
    }
#if MK_FP8 && MK_DN_FILL
    for (int it = DN_FIRST + gw; it < DNF_ITEMS; it += NGW) { const int e = it >> 11, q = it & 2047, kb = q >> 6, nb = q & 63;
        p0_transpose_item_f8(F.w_down + (size_t)e * D * D, D, WSP(unsigned char, WS_WDNT) + (size_t)e * D * D, D, kb * 64, nb * 32, nb * 32, scr, F.lane); }
#endif
}

__device__ __forceinline__ void p1_gates(Frame& F, int gi, int GG_) {
    const int blk = F.wave * GG_ + gi;
    LAS bf16_t* lrs = (LAS bf16_t*)(F.lds + F.wave * 2048);
    if (blk < NTOK / 16) {
        const int tok0 = blk * 16, fr = F.lane & 15, fq = F.lane >> 4;
        const bf16_t* xa = WSP(bf16_t, WS_XN) + (size_t)(tok0 + fr) * D + fq * 8;
        const bf16_t* wl0 = WSP(bf16_t, WS_WLRT) + (size_t)fr * D + fq * 8; const bf16_t* wl1 = wl0 + (size_t)16 * D;
        f32x4 a0 = {0.f, 0.f, 0.f, 0.f}, a1 = {0.f, 0.f, 0.f, 0.f};
#pragma unroll 4
        for (int ks = 0; ks < 64; ++ks) { const bf16x8 a = *(const bf16x8*)(xa + ks * 32), b0 = *(const bf16x8*)(wl0 + ks * 32), b1 = *(const bf16x8*)(wl1 + ks * 32);
            a0 = __builtin_amdgcn_mfma_f32_16x16x32_bf16(a, b0, a0, 0, 0, 0); a1 = __builtin_amdgcn_mfma_f32_16x16x32_bf16(a, b1, a1, 0, 0, 0); }
#pragma unroll
        for (int i = 0; i < 4; ++i) { lrs[(0 * 16 + 4 * fq + i) * 32 + fr] = (bf16_t)f2bf(a0[i]); lrs[(1 * 16 + 4 * fq + i) * 32 + fr] = (bf16_t)f2bf(a1[i]); lrs[(0 * 16 + 4 * fq + i) * 32 + 16 + fr] = 0; lrs[(1 * 16 + 4 * fq + i) * 32 + 16 + fr] = 0; }
        LDS_WAIT(); asm volatile("" ::: "memory");
#pragma unroll
        for (int d = 0; d < 2; ++d) {
            const bf16x8 lrf = *(const LAS bf16x8*)(lrs + (d * 16 + fr) * 32 + fq * 8);
            const bf16_t* w2p = WSP(bf16_t, WS_W2T) + ((size_t)d * 512 + fr) * 32 + fq * 8;
            const float* bp = F.gla_b + d * 512 + 4 * fq;
            bf16_t* gout = WSP(bf16_t, WS_GGLA) + (size_t)(tok0 + fr) * 1024 + d * 512 + 4 * fq;
#pragma unroll 4
            for (int ct = 0; ct < 32; ++ct) {
                const bf16x8 wa = *(const bf16x8*)(w2p + (size_t)ct * 16 * 32);
                f32x4 lg = __builtin_amdgcn_mfma_f32_16x16x32_bf16(wa, lrf, (f32x4){0.f, 0.f, 0.f, 0.f}, 0, 0, 0);
                const f32x4 bb = *(const f32x4*)(bp + ct * 16); float g[4];
#pragma unroll
                for (int i = 0; i < 4; ++i) { const float x = lg[i] + bb[i]; g[i] = (fminf(x, 0.f) - __logf(1.f + __expf(-fabsf(x)))) * (1.f / 16.f); }
                u32x2 w; w.x = cvt_pk_bf16(g[0], g[1]); w.y = cvt_pk_bf16(g[2], g[3]);
                *(u32x2*)(gout + ct * 16) = w;
            }
        }
    }
    VM_WAIT(); __syncthreads();
}

constexpr int RQ_PQ = 272, RQ_PT = 144;
constexpr int RL_QS = 0, RL_KS = 17408, RL_KT = 34816, RL_VT = 53248, RL_ST = 71680, RL_VEC = 106496;
static_assert(RL_VEC + 1536 <= RING_BYTES, "recurrence LDS map");
__device__ __forceinline__ float scan64(float v) {
    int t;
    t = __builtin_amdgcn_update_dpp(0, __builtin_bit_cast(int, v), 0x111, 0xf, 0xf, true); v += __builtin_bit_cast(float, t);
    t = __builtin_amdgcn_update_dpp(0, __builtin_bit_cast(int, v), 0x112, 0xf, 0xf, true); v += __builtin_bit_cast(float, t);
    t = __builtin_amdgcn_update_dpp(0, __builtin_bit_cast(int, v), 0x114, 0xf, 0xf, true); v += __builtin_bit_cast(float, t);
    t = __builtin_amdgcn_update_dpp(0, __builtin_bit_cast(int, v), 0x118, 0xf, 0xf, true); v += __builtin_bit_cast(float, t);
    t = __builtin_amdgcn_update_dpp(0, __builtin_bit_cast(int, v), 0x142, 0xa, 0xf, false); v += __builtin_bit_cast(float, t);
    t = __builtin_amdgcn_update_dpp(0, __builtin_bit_cast(int, v), 0x143, 0xc, 0xf, false); v += __builtin_bit_cast(float, t);
    return v;
}
#define RECUR_ISSUE(n_) do { const int cidx_ = dir ? 31 - (n_) : (n_); const size_t tq_ = (size_t)(b * TSEQ + cidx_ * 64 + (dir ? 63 - lane : lane)); \
            const u32x4* qp_ = (const u32x4*)(Z + tq_ * NZ + qcol); pq[0] = qp_[0]; pq[1] = qp_[1]; \
            const u32x4* gp_ = (const u32x4*)(gbase + tq_ * gpitch); pg[0] = gp_[0]; pg[1] = gp_[1]; \
            { const u32x4* kp_ = gla ? (const u32x4*)(Z + tq_ * NZ + kcol) : gp_; pk[0] = kp_[0]; pk[1] = kp_[1]; } \
            const u32x4* vp_ = (const u32x4*)(Z + tq_ * NZ + vcol); pv[0] = vp_[0]; pv[1] = vp_[1]; } while (0)
constexpr int GU_ITEMS = 32 * 16 * 128;
#define GU_FILL_ISSUE(it_) do { { const int itc_ = (it_) < GU_ITEMS ? (it_) : GU_ITEMS - 1; const int e_ = __builtin_amdgcn_readfirstlane(itc_ >> 11), q_ = __builtin_amdgcn_readfirstlane(itc_ & 2047); \
        const char* ub_ = (const char*)F.w_gate_up + ((size_t)e_ * D * 4096 + (size_t)((q_ >> 7) * 128) * 4096 + (size_t)(q_ & 127) * 32) * 4; \
        _Pragma("unroll") for (int i_ = 0; i_ < 16; ++i_) fv[i_] = __builtin_nontemporal_load((const f32x4*)(ub_ + (size_t)i_ * 16384 + fvoff_ld)); } asm volatile("" ::: "memory"); } while (0)
#define GU_FILL_ISSUE_PART(it_, i0_, i1_) do { { const int itc_ = (it_) < GU_ITEMS ? (it_) : GU_ITEMS - 1; const int e_ = __builtin_amdgcn_readfirstlane(itc_ >> 11), q_ = __builtin_amdgcn_readfirstlane(itc_ & 2047); \
        const char* ub_ = (const char*)F.w_gate_up + ((size_t)e_ * D * 4096 + (size_t)((q_ >> 7) * 128) * 4096 + (size_t)(q_ & 127) * 32) * 4; \
        _Pragma("unroll") for (int i_ = (i0_); i_ < (i1_); ++i_) fv[i_] = __builtin_nontemporal_load((const f32x4*)(ub_ + (size_t)i_ * 16384 + fvoff_ld)); } asm volatile("" ::: "memory"); } while (0)
#define GU_FILL_STORE(it_) do { { const int itc_ = (it_) < GU_ITEMS ? (it_) : GU_ITEMS - 1; const int e_ = __builtin_amdgcn_readfirstlane(itc_ >> 11), q_ = __builtin_amdgcn_readfirstlane(itc_ & 2047); \
        unsigned char* ud_ = WSP(unsigned char, MK_GU_PROBE ? WS_ACT : WS_WGUT) + (size_t)e_ * 4096 * D + (size_t)((q_ & 127) * 32) * D + (q_ >> 7) * 128; \
        if (MK_GU_PROBE == 2) { _Pragma("unroll") for (int i_ = 0; i_ < 16; ++i_) asm volatile("" :: "v"(fv[i_])); } else \
        _Pragma("unroll") for (int j_ = 0; j_ < 4; ++j_) { unsigned w_[4]; \
            _Pragma("unroll") for (int d_ = 0; d_ < 4; ++d_) { const unsigned t_ = __builtin_amdgcn_cvt_pk_fp8_f32(fv[4 * d_][j_] * 256.f, fv[4 * d_ + 1][j_] * 256.f, 0u, false); w_[d_] = __builtin_amdgcn_cvt_pk_fp8_f32(fv[4 * d_ + 2][j_] * 256.f, fv[4 * d_ + 3][j_] * 256.f, t_, true); } \
            *(u32x4*)(ud_ + fvoff_st + (size_t)j_ * D) = (u32x4){w_[0], w_[1], w_[2], w_[3]}; } } } while (0)
__device__ __forceinline__ void recur_item(Frame& F, int item) {
    LAS unsigned char* L = F.lds;
    const int lane = F.lane, w = F.wave, fr = lane & 15, fq = lane >> 4;
    const bool gla = item >= 128; const int j_ = item & 127;
    const int b = j_ >> 4, dir = j_ & 1, h = gla ? (j_ >> 2) & 3 : (j_ >> 1) & 7, half = (j_ >> 1) & 1;
    const bf16_t* Z = WSP(bf16_t, WS_ZB); bf16_t* OB = WSP(bf16_t, dir ? WS_OBUF2 : WS_OBUF);
    const int qcol = (gla ? Z_GQ : Z_HQ) + h * 128 + 16 * w, kcol = Z_GK + h * 128 + 16 * w;
    const int vcol = (gla ? Z_GV + h * 256 + half * 128 : Z_HI + h * 128) + 16 * w;
    const int ocol = gla ? 1024 + h * 256 + half * 128 : h * 128;
    const bf16_t* gbase = gla ? WSP(bf16_t, WS_GGLA) + dir * 512 + h * 128 + 16 * w : Z + (dir ? Z_HFB : Z_HFF) + h * 128 + 16 * w; const size_t gpitch = gla ? 1024 : NZ;
    const int tr = w >> 1, h2 = w & 1;
    f32x4 st[8];
#pragma unroll
    for (int vt = 0; vt < 8; ++vt) st[vt] = (f32x4){0.f, 0.f, 0.f, 0.f};
    u32x4 pq[2], pk[2], pg[2], pv[2];
    pk[0] = (u32x4){0u, 0u, 0u, 0u}; pk[1] = pk[0];
    RECUR_ISSUE(0);
#if MK_FP8 && MK_GU_IN_P2
    const unsigned fvoff_ld = (unsigned)((16 * (lane >> 3)) * 4096 + 4 * (lane & 7)) * 4u, fvoff_st = (unsigned)((4 * (lane & 7)) * D + 16 * (lane >> 3));
    f32x4 fv[16]; const int fgw = F.vcu * NWAVES + w, FNGW = F.G * NWAVES;
#endif
#pragma unroll 1
    for (int n = 0; n < 32; ++n) {
        const int cidx = dir ? 31 - n : n;
        float q[16], kk[16], bb[16];
        {
            const unsigned qa[8] = {pq[0].x, pq[0].y, pq[0].z, pq[0].w, pq[1].x, pq[1].y, pq[1].z, pq[1].w};
            const unsigned ka[8] = {pk[0].x, pk[0].y, pk[0].z, pk[0].w, pk[1].x, pk[1].y, pk[1].z, pk[1].w};
            const unsigned ga[8] = {pg[0].x, pg[0].y, pg[0].z, pg[0].w, pg[1].x, pg[1].y, pg[1].z, pg[1].w};
#pragma unroll
            for (int j = 0; j < 8; ++j) { q[2 * j] = bf_lo(qa[j]); q[2 * j + 1] = bf_hi(qa[j]); kk[2 * j] = bf_lo(ka[j]); kk[2 * j + 1] = bf_hi(ka[j]); bb[2 * j] = bf_lo(ga[j]); bb[2 * j + 1] = bf_hi(ga[j]); }
        }
        if (!gla) {
#pragma unroll
            for (int j = 0; j < 16; ++j) kk[j] = 1.f - __expf(bb[j]);
        }
        const u32x4 va0 = pv[0], va1 = pv[1];
#pragma unroll
        for (int j = 0; j < 16; ++j) bb[j] = scan64(bb[j]);
        float myr = 0.f, mybl = 0.f;
        unsigned qw[8], kw[8]; unsigned short kt16[16];
#pragma unroll
        for (int j = 0; j < 16; ++j) {
            const float r = __builtin_bit_cast(float, __builtin_amdgcn_readlane(__builtin_bit_cast(int, bb[j]), 31));
            const float bl = __builtin_bit_cast(float, __builtin_amdgcn_readlane(__builtin_bit_cast(int, bb[j]), 63));
            if (lane == j) { myr = r; mybl = bl; }
            const float dlt = fminf(fmaxf(bb[j] - r, -60.f), 60.f);
            const float eq = __expf(dlt), ek = __builtin_amdgcn_rcpf(eq);
            q[j] *= eq; kk[j] *= ek;
        }
#pragma unroll
        for (int j = 0; j < 8; ++j) { qw[j] = pk2(q[2 * j], q[2 * j + 1]); kw[j] = pk2(kk[2 * j], kk[2 * j + 1]); kt16[2 * j] = (unsigned short)(kw[j] & 0xffffu); kt16[2 * j + 1] = (unsigned short)(kw[j] >> 16); }
        const float e_r = __expf(fmaxf(myr, -80.f)), e_l = __expf(fmaxf(mybl, -80.f)), e_d = __expf(fmaxf(mybl - myr, -80.f));
#if MK_FP8 && MK_GU_IN_P2
        if (n > 0) GU_FILL_STORE(((n - 1 > MK_GU_P2_SKIP ? n - 1 : MK_GU_P2_SKIP) - MK_GU_P2_SKIP) * FNGW + fgw);
#endif
        __syncthreads();
#pragma unroll
        for (int j = 0; j < 16; ++j) *(LAS bf16_t*)(L + RL_KT + (16 * w + j) * RQ_PT + lane * 2) = kt16[j];
        *(LAS u32x4*)(L + RL_QS + lane * RQ_PQ + 32 * w) = (u32x4){qw[0], qw[1], qw[2], qw[3]}; *(LAS u32x4*)(L + RL_QS + lane * RQ_PQ + 32 * w + 16) = (u32x4){qw[4], qw[5], qw[6], qw[7]};
        *(LAS u32x4*)(L + RL_KS + lane * RQ_PQ + 32 * w) = (u32x4){kw[0], kw[1], kw[2], kw[3]}; *(LAS u32x4*)(L + RL_KS + lane * RQ_PQ + 32 * w + 16) = (u32x4){kw[4], kw[5], kw[6], kw[7]};
        { const unsigned vw[8] = {va0.x, va0.y, va0.z, va0.w, va1.x, va1.y, va1.z, va1.w};
#pragma unroll
          for (int j = 0; j < 8; ++j) { *(LAS bf16_t*)(L + RL_VT + (16 * w + 2 * j) * RQ_PT + lane * 2) = (bf16_t)(vw[j] & 0xffffu); *(LAS bf16_t*)(L + RL_VT + (16 * w + 2 * j + 1) * RQ_PT + lane * 2) = (bf16_t)(vw[j] >> 16); } }
        if (lane < 16) { LAS float* vec = (LAS float*)(L + RL_VEC); vec[16 * w + lane] = e_r; vec[128 + 16 * w + lane] = e_l; vec[256 + 16 * w + lane] = e_d; }
        RECUR_ISSUE(n + 1 < 32 ? n + 1 : 31);
        LDS_WAIT();
        const f32x4 er = *(const LAS f32x4*)(L + RL_VEC + (16 * w + 4 * fq) * 4), dl = *(const LAS f32x4*)(L + RL_VEC + (128 + 16 * w + 4 * fq) * 4), dr = *(const LAS f32x4*)(L + RL_VEC + (256 + 16 * w + 4 * fq) * 4);
#pragma unroll
        for (int vt = 0; vt < 8; ++vt) { u32x2 sw; sw.x = pk2(st[vt][0] * er[0], st[vt][1] * er[1]); sw.y = pk2(st[vt][2] * er[2], st[vt][3] * er[3]);
            *(LAS u32x2*)(L + RL_ST + (16 * vt + fr) * RQ_PQ + (16 * w + 4 * fq) * 2) = sw; }
        LDS_WAIT(); __syncthreads();
#if MK_FP8 && MK_GU_IN_P2
        GU_FILL_ISSUE_PART(((n > MK_GU_P2_SKIP ? n : MK_GU_P2_SKIP) - MK_GU_P2_SKIP) * FNGW + fgw, 0, MK_GU_SPLIT);
#endif
        bf16x8 bqf[4];
#pragma unroll
        for (int ks = 0; ks < 4; ++ks) bqf[ks] = *(const LAS bf16x8*)(L + RL_QS + (16 * tr + fr) * RQ_PQ + ks * 64 + fq * 16);
        f32x4 sc[4];
#pragma unroll
        for (int tc = 0; tc < 4; ++tc) { sc[tc] = (f32x4){0.f, 0.f, 0.f, 0.f};
            if (tc <= tr) {
#pragma unroll
                for (int ks = 0; ks < 4; ++ks) { const bf16x8 a = *(const LAS bf16x8*)(L + RL_KS + (16 * tc + fr) * RQ_PQ + ks * 64 + fq * 16);
                    sc[tc] = __builtin_amdgcn_mfma_f32_16x16x32_bf16(a, bqf[ks], sc[tc], 0, 0, 0); }
                if (tc == tr) {
#pragma unroll
                    for (int i = 0; i < 4; ++i) if (4 * fq + i > fr) sc[tc][i] = 0.f;
                }
            } }
        bf16x8 pf[2];
#pragma unroll
        for (int ks = 0; ks < 2; ++ks) { const u32x4 t4 = {pk2(sc[2 * ks][0], sc[2 * ks][1]), pk2(sc[2 * ks][2], sc[2 * ks][3]), pk2(sc[2 * ks + 1][0], sc[2 * ks + 1][1]), pk2(sc[2 * ks + 1][2], sc[2 * ks + 1][3])}; pf[ks] = __builtin_bit_cast(bf16x8, t4); }
        const size_t trow = (size_t)(b * TSEQ + cidx * 64 + (dir ? 63 - (16 * tr + fr) : (16 * tr + fr)));
#pragma unroll
        for (int vv = 0; vv < 4; ++vv) { const int vt = 4 * h2 + vv;
            f32x4 o = {0.f, 0.f, 0.f, 0.f};
#pragma unroll
            for (int ks = 0; ks < 2; ++ks) { if (ks == 0 || tr >= 2) {
                const u32x2 a0 = *(const LAS u32x2*)(L + RL_VT + (16 * vt + fr) * RQ_PT + (32 * ks + 4 * fq) * 2), a1 = *(const LAS u32x2*)(L + RL_VT + (16 * vt + fr) * RQ_PT + (32 * ks + 16 + 4 * fq) * 2);
                const u32x4 a4 = {a0.x, a0.y, a1.x, a1.y};
                o = __builtin_amdgcn_mfma_f32_16x16x32_bf16(__builtin_bit_cast(bf16x8, a4), pf[ks], o, 0, 0, 0); } }
#pragma unroll
            for (int ks = 0; ks < 4; ++ks) { const bf16x8 a = *(const LAS bf16x8*)(L + RL_ST + (16 * vt + fr) * RQ_PQ + ks * 64 + fq * 16);
                o = __builtin_amdgcn_mfma_f32_16x16x32_bf16(a, bqf[ks], o, 0, 0, 0); }
            *(u32x2*)(OB + trow * D + ocol + 16 * vt + 4 * fq) = (u32x2){pk2(o[0], o[1]), pk2(o[2], o[3])}; }
#if MK_FP8 && MK_GU_IN_P2
        GU_FILL_ISSUE_PART(((n > MK_GU_P2_SKIP ? n : MK_GU_P2_SKIP) - MK_GU_P2_SKIP) * FNGW + fgw, MK_GU_SPLIT, 16);
#endif
        bf16x8 ktf[2];
#pragma unroll
        for (int ks = 0; ks < 2; ++ks) ktf[ks] = *(const LAS bf16x8*)(L + RL_KT + (16 * w + fr) * RQ_PT + ks * 64 + fq * 16);
#pragma unroll
        for (int vt = 0; vt < 8; ++vt) { f32x4 ds = {0.f, 0.f, 0.f, 0.f};
#pragma unroll
            for (int ks = 0; ks < 2; ++ks) { const bf16x8 bv = *(const LAS bf16x8*)(L + RL_VT + (16 * vt + fr) * RQ_PT + ks * 64 + fq * 16);
                ds = __builtin_amdgcn_mfma_f32_16x16x32_bf16(ktf[ks], bv, ds, 0, 0, 0); }
            st[vt] = st[vt] * dl + ds * dr; }
        LDS_WAIT();
    }
#if MK_FP8 && MK_GU_IN_P2
    GU_FILL_STORE((31 - MK_GU_P2_SKIP) * FNGW + fgw);
    for (int it = GU_ITEMS + fgw; it < GU_ITEMS; it += FNGW) { GU_FILL_ISSUE(it); GU_FILL_STORE(it); }
#endif
    __syncthreads();
}

__device__ __forceinline__ void p3_combine(Frame& F) {
    const int gw = F.vcu * NWAVES + F.wave, NGW = F.G * NWAVES, lane = F.lane;
    const bf16_t* Z = WSP(bf16_t, WS_ZB); const bf16_t* OB = WSP(bf16_t, WS_OBUF); const bf16_t* OB2 = WSP(bf16_t, WS_OBUF2);
    for (int tok = gw; tok < NTOK; tok += NGW) {
#pragma unroll
        for (int mx = 0; mx < 2; ++mx) {
            const u32x4* op = (const u32x4*)(OB + (size_t)tok * D + mx * 1024 + 16 * lane); const u32x4* op2 = (const u32x4*)(OB2 + (size_t)tok * D + mx * 1024 + 16 * lane);
            const u32x4 a0 = __builtin_nontemporal_load(op), a1 = __builtin_nontemporal_load(op + 1), b0 = __builtin_nontemporal_load(op2), b1 = __builtin_nontemporal_load(op2 + 1);
            const unsigned aw[8] = {a0.x, a0.y, a0.z, a0.w, a1.x, a1.y, a1.z, a1.w}, bw[8] = {b0.x, b0.y, b0.z, b0.w, b1.x, b1.y, b1.z, b1.w};
            f32x4 v[4]; float s = 0.f;
#pragma unroll
            for (int j = 0; j < 4; ++j) { v[j] = (f32x4){bf_lo(aw[2 * j]) + bf_lo(bw[2 * j]), bf_hi(aw[2 * j]) + bf_hi(bw[2 * j]), bf_lo(aw[2 * j + 1]) + bf_lo(bw[2 * j + 1]), bf_hi(aw[2 * j + 1]) + bf_hi(bw[2 * j + 1])};
                s += (v[j].x * v[j].x + v[j].y * v[j].y) + (v[j].z * v[j].z + v[j].w * v[j].w); }
            s += __shfl_xor(s, 1); s += __shfl_xor(s, 2); s += __shfl_xor(s, 4); if (mx) s += __shfl_xor(s, 8);
            const float r = rsqrtf(s * (mx ? 1.f / 256.f : 1.f / 128.f) + RMS_EPS);
            const float* gp = (mx ? F.gla_norm_g + ((16 * lane) & 255) : F.hg_norm_g + ((16 * lane) & 127));
            const u32x4* zp = (const u32x4*)(Z + (size_t)tok * NZ + (mx ? Z_GR : Z_HOG) + 16 * lane); const u32x4 z0 = zp[0], z1 = zp[1];
            const unsigned za[8] = {z0.x, z0.y, z0.z, z0.w, z1.x, z1.y, z1.z, z1.w}; unsigned ow[8];
#pragma unroll
            for (int j = 0; j < 4; ++j) { const f32x4 gg = *(const f32x4*)(gp + 4 * j);
                float g0 = bf_lo(za[2 * j]), g1 = bf_hi(za[2 * j]), g2 = bf_lo(za[2 * j + 1]), g3 = bf_hi(za[2 * j + 1]);
#if MK_SILU_P3
                g0 *= fsigm(g0); g1 *= fsigm(g1); g2 *= fsigm(g2); g3 *= fsigm(g3);
#endif
                ow[2 * j] = pk2(v[j].x * r * gg.x * g0, v[j].y * r * gg.y * g1); ow[2 * j + 1] = pk2(v[j].z * r * gg.z * g2, v[j].w * r * gg.w * g3); }
#if MK_FP8_PO
            unsigned o8[4];
#pragma unroll
            for (int j = 0; j < 4; ++j) { const unsigned t8 = __builtin_amdgcn_cvt_pk_fp8_f32(bf_lo(ow[2 * j]), bf_hi(ow[2 * j]), 0u, false); o8[j] = __builtin_amdgcn_cvt_pk_fp8_f32(bf_lo(ow[2 * j + 1]), bf_hi(ow[2 * j + 1]), t8, true); }
            *(u32x4*)(WSP(unsigned char, mx ? WS_YB : WS_YA) + (size_t)tok * 1024 + 16 * lane) = (u32x4){o8[0], o8[1], o8[2], o8[3]};
#else
            u32x4* yo = (u32x4*)(WSP(bf16_t, mx ? WS_YB : WS_YA) + (size_t)tok * 1024 + 16 * lane);
            yo[0] = (u32x4){ow[0], ow[1], ow[2], ow[3]}; yo[1] = (u32x4){ow[4], ow[5], ow[6], ow[7]};
#endif
        }
    }
}

constexpr int R_HN = 0, R_PART = 65536, R_LOG = R_PART + 8 * 8 * 32 * 4, R_TK = R_LOG + 8 * 32 * 4, R_CNT = R_TK + 4096;
static_assert(R_CNT + 256 <= RING_BYTES, "router LDS map");
#ifndef MK_H1_P6
#define MK_H1_P6 1
#endif

__device__ __forceinline__ void p6_router(Frame& F) {
    LAS unsigned char* L = F.lds; const int tid = F.tid, lane = F.lane, w = F.wave;
    LAS float* hnl = (LAS float*)(L + R_HN); LAS float* part = (LAS float*)(L + R_PART); LAS float* logit = (LAS float*)(L + R_LOG);
    LAS int* tk_idx = (LAS int*)(L + R_TK); LAS float* tk_p = (LAS float*)(L + R_TK + 1024);
    LAS int* lcnt = (LAS int*)(L + R_CNT); LAS int* lbase = lcnt + 32;
    const int eq = tid & 7, ds = tid >> 3;
    f32x4 wreg[32];
#pragma unroll
    for (int j = 0; j < 32; ++j) wreg[j] = *(const f32x4*)(F.router_w + (size_t)(ds * 32 + j) * NE + 4 * eq);
    const int TPW = NTOK / F.G;
    if (tid < 32) lcnt[tid] = 0;
    const bf16_t* MIX = WSP(bf16_t, WS_H1); bf16_t* HN = (bf16_t*)(F.ws + (MK_P6_XN ? WS_XN8 : WS_XN));

    const f32x4* gr = (const f32x4*)F.norm2_g + lane;
    f32x4 vn[8];
#if MK_H1_BF16
#define P6_LOAD_ROW(tok_) do { const u32x2* mr_ = (const u32x2*)(MIX + (size_t)(tok_) * D) + lane; \
        _Pragma("unroll") for (int j = 0; j < 8; ++j) { const u32x2 mv_ = mr_[64 * j]; vn[j] = (f32x4){bf_lo(mv_.x), bf_hi(mv_.x), bf_lo(mv_.y), bf_hi(mv_.y)}; } } while (0)
#elif MK_P6_XN
#define P6_LOAD_ROW(tok_) do { const u32x2* xr_ = (const u32x2*)(WSP(bf16_t, WS_XN) + (size_t)(tok_) * D) + lane; const u32x2* mr_ = (const u32x2*)(MIX + (size_t)(tok_) * D) + lane; const float rr_ = WSP(float, WS_RR)[tok_]; \
        _Pragma("unroll") for (int j = 0; j < 8; ++j) { const u32x2 xv_ = xr_[64 * j]; const u32x2 mv_ = mr_[64 * j]; \
            vn[j] = (f32x4){bf_lo(xv_.x) * rr_ + bf_lo(mv_.x), bf_hi(xv_.x) * rr_ + bf_hi(mv_.x), bf_lo(xv_.y) * rr_ + bf_lo(mv_.y), bf_hi(xv_.y) * rr_ + bf_hi(mv_.y)}; } } while (0)
#else
#define P6_LOAD_ROW(tok_) do { const f32x4* xr_ = (const f32x4*)(F.x + (size_t)(tok_) * D) + lane; const u32x2* mr_ = (const u32x2*)(MIX + (size_t)(tok_) * D) + lane; \
        _Pragma("unroll") for (int j = 0; j < 8; ++j) { const f32x4 xv_ = xr_[64 * j]; const u32x2 mv_ = mr_[64 * j]; vn[j] = (f32x4){xv_.x + bf_lo(mv_.x), xv_.y + bf_hi(mv_.x), xv_.z + bf_lo(mv_.y), xv_.w + bf_hi(mv_.y)}; } } while (0)
#endif
    P6_LOAD_ROW(F.vcu * TPW + w);
#pragma unroll 1
    for (int bt = 0; bt < TPW / 8; ++bt) {
        const int tok = F.vcu * TPW + bt * 8 + w;
        {
            float s = 0.f;
#pragma unroll
            for (int j = 0; j < 8; ++j) s += (vn[j].x * vn[j].x + vn[j].y * vn[j].y) + (vn[j].z * vn[j].z + vn[j].w * vn[j].w);
            const float r = rsqrtf(wave_sum(s) * (1.f / D) + RMS_EPS);
            u32x2* o8 = (u32x2*)(HN + (size_t)tok * D) + lane;
#pragma unroll
            for (int j = 0; j < 8; ++j) { const f32x4 gg = gr[64 * j]; const f32x4 y = {vn[j].x * r * gg.x, vn[j].y * r * gg.y, vn[j].z * r * gg.z, vn[j].w * r * gg.w};
                *(LAS f32x4*)(hnl + w * 2048 + 4 * (lane + 64 * j)) = y;
#if MK_H1_P6
                ((u32x2*)(WSP(bf16_t, WS_H1) + (size_t)tok * D) + lane)[64 * j] = (u32x2){pk2(vn[j].x, vn[j].y), pk2(vn[j].z, vn[j].w)};
#endif
#if MK_FP8
                unsigned w8 = __builtin_amdgcn_cvt_pk_fp8_f32(y.x, y.y, 0u, false); w8 = __builtin_amdgcn_cvt_pk_fp8_f32(y.z, y.w, w8, true);
                ((unsigned*)((unsigned char*)HN + (size_t)tok * D))[lane + 64 * j] = w8; (void)o8;
#else
                u32x2 ww; ww.x = pk2(y.x, y.y); ww.y = pk2(y.z, y.w); o8[64 * j] = ww;
#endif
            }
        }
        LDS_WAIT(); __syncthreads();
        if (bt + 1 < TPW / 8) P6_LOAD_ROW(tok + 8);
#pragma unroll 2
        for (int t8 = 0; t8 < 8; ++t8) { f32x4 a = {0.f, 0.f, 0.f, 0.f}; const LAS f32x4* hp = (const LAS f32x4*)(hnl + t8 * 2048 + ds * 32);
#pragma unroll
            for (int j = 0; j < 8; ++j) { const f32x4 hv = hp[j]; a += wreg[4 * j] * hv.x; a += wreg[4 * j + 1] * hv.y; a += wreg[4 * j + 2] * hv.z; a += wreg[4 * j + 3] * hv.w; }
#pragma unroll
            for (int i = 0; i < 4; ++i) { float x = a[i]; x += __shfl_xor(x, 8); x += __shfl_xor(x, 16); x += __shfl_xor(x, 32); a[i] = x; }
            if (lane < 8) *(LAS f32x4*)(part + (t8 * 8 + w) * 32 + 4 * eq) = a; }
        LDS_WAIT(); __syncthreads();
        if (tid < 256) { const int t8 = tid >> 5, e = tid & 31; float a = F.router_b[e];
#pragma unroll
            for (int d2 = 0; d2 < 8; ++d2) a += part[(t8 * 8 + d2) * 32 + e];
            logit[t8 * 32 + e] = a; }
        LDS_WAIT(); __syncthreads();
        if (tid < 8) { float val[4]; int idx[4]; unsigned used = 0u;
            for (int k = 0; k < 4; ++k) { float best = -3.4e38f; int bi = 0; for (int i = 0; i < 32; ++i) { const float v = logit[tid * 32 + i]; if (!((used >> i) & 1u) && v > best) { best = v; bi = i; } } used |= 1u << bi; val[k] = best; idx[k] = bi; }
            float p[4], s = 0.f; for (int k = 0; k < 4; ++k) { p[k] = __expf(val[k] - val[0]); s += p[k]; }
            const float inv = 1.f / s;
            for (int k = 0; k < 4; ++k) { const int slot = (bt * 8 + tid) * 4 + k; tk_idx[slot] = idx[k]; tk_p[slot] = p[k] * inv; } }
    }
    LDS_WAIT(); __syncthreads();
    const int npair = TPW * 4;
    int my_e = 0, my_lr = 0;
    if (tid < npair) { my_e = tk_idx[tid]; my_lr = __hip_atomic_fetch_add(lcnt + my_e, 1, __ATOMIC_RELAXED, __HIP_MEMORY_SCOPE_WORKGROUP); }
    LDS_WAIT(); __syncthreads();
    if (tid < 32) lbase[tid] = (int)__hip_atomic_fetch_add((unsigned*)F.ctl + CW_ECNT + 64 * tid, (unsigned)lcnt[tid], __ATOMIC_RELAXED, __HIP_MEMORY_SCOPE_AGENT);
    LDS_WAIT(); __syncthreads();
    if (tid < npair) { const int rank = lbase[my_e] + my_lr; const int tok = F.vcu * TPW + (tid >> 2);
        WSP(int, WS_ROWTOK)[(size_t)my_e * NTOK + rank] = tok; WSP(float, WS_ROWW)[(size_t)my_e * NTOK + rank] = tk_p[tid]; WSP(int, WS_PAIR)[tok * 4 + (tid & 3)] = (my_e << 16) | rank; }
}
__device__ __forceinline__ void build_tab(Frame& F) {
    volatile LAS int* tab = (volatile LAS int*)(F.lds + LDS_TAB);
    if (F.tid < 32) { const int c = (int)__hip_atomic_load((unsigned*)F.ctl + CW_ECNT + 64 * F.tid, __ATOMIC_RELAXED, __HIP_MEMORY_SCOPE_AGENT); tab[F.tid] = c; tab[32 + F.tid] = (c + 255) >> 8; }
    LDS_WAIT(); __syncthreads();
    if (F.tid == 0) { int a = 0; for (int e = 0; e < NE; ++e) { tab[64 + e] = a; a += tab[32 + e]; } tab[96] = a; tab[100] = a; }
    LDS_WAIT(); __syncthreads();
    if (F.tid < 320) { int e = 0; while (e < NE - 1 && F.tid >= tab[64 + e + 1]) ++e; tab[128 + F.tid] = e; }
#if MK_HALF_TILES
    if (F.tid < 32) { const int c = tab[F.tid], nm = tab[32 + F.tid]; const int hf = (nm > 0 && c - 256 * (nm - 1) <= 128) ? 1 : 0; tab[TAB_NMF + F.tid] = nm - hf; }
    LDS_WAIT(); __syncthreads();
    if (F.tid == 0) { int a = 0, h = 0; for (int e = 0; e < NE; ++e) { tab[TAB_TBF + e] = a; a += tab[TAB_NMF + e]; if (tab[TAB_NMF + e] != tab[32 + e]) tab[TAB_HIDX + h++] = e; } tab[TAB_TBF + NE] = a; tab[TAB_NTF] = a; tab[TAB_NTH] = h; }
    LDS_WAIT(); __syncthreads();
    if (F.tid < 320) { int e = 0; while (e < NE - 1 && F.tid >= tab[TAB_TBF + e + 1]) ++e; tab[TAB_EOF + F.tid] = e; }
#endif
    LDS_WAIT(); __syncthreads();
}
__device__ __forceinline__ void p9_final(Frame& F) {
    const int gw = F.vcu * NWAVES + F.wave, NGW = F.G * NWAVES, lane = F.lane;
    const volatile LAS int* tab = (const volatile LAS int*)(F.lds + LDS_TAB);
    const bf16_t* MIX = WSP(bf16_t, WS_H1); const unsigned char* YP = WSP(unsigned char, WS_YPAIR); const int* PR = WSP(int, WS_PAIR);
    for (int tok = gw; tok < NTOK; tok += NGW) {
        f32x4 v[8]; const f32x4* hr = (const f32x4*)(F.x + (size_t)tok * D) + lane; const u32x2* mr = (const u32x2*)(MIX + (size_t)tok * D) + lane;
#if MK_H1_BF16 || MK_H1_P6
#pragma unroll
        for (int j = 0; j < 8; ++j) { const u32x2 mv = __builtin_nontemporal_load(mr + 64 * j); v[j] = (f32x4){bf_lo(mv.x), bf_hi(mv.x), bf_lo(mv.y), bf_hi(mv.y)}; }
        (void)hr;
#else
#pragma unroll
        for (int j = 0; j < 8; ++j) { const f32x4 xv = __builtin_nontemporal_load(hr + 64 * j); const u32x2 mv = __builtin_nontemporal_load(mr + 64 * j); v[j] = (f32x4){xv.x + bf_lo(mv.x), xv.y + bf_hi(mv.x), xv.z + bf_lo(mv.y), xv.w + bf_hi(mv.y)}; }
#endif
#pragma unroll
        for (int k = 0; k < 4; ++k) { const int pr = PR[tok * 4 + k]; const int e = pr >> 16, rank = pr & 0xffff; const size_t pos = (size_t)tab[64 + e] * 256 + rank;
            const unsigned* yr = (const unsigned*)(YP + pos * D) + lane;
#pragma unroll
            for (int j = 0; j < 8; ++j) { const unsigned y = __builtin_nontemporal_load(yr + 64 * j);
                v[j].x += __builtin_amdgcn_cvt_f32_fp8(y, 0) * 0.0625f; v[j].y += __builtin_amdgcn_cvt_f32_fp8(y, 1) * 0.0625f; v[j].z += __builtin_amdgcn_cvt_f32_fp8(y, 2) * 0.0625f; v[j].w += __builtin_amdgcn_cvt_f32_fp8(y, 3) * 0.0625f; } }
        float s = 0.f;
#pragma unroll
        for (int j = 0; j < 8; ++j) s += (v[j].x * v[j].x + v[j].y * v[j].y) + (v[j].z * v[j].z + v[j].w * v[j].w);
        const float r = rsqrtf(wave_sum(s) * (1.f / D) + RMS_EPS);
        f32x4* o = (f32x4*)(F.out + (size_t)tok * D) + lane; const f32x4* gr = (const f32x4*)F.final_g + lane;
#pragma unroll
        for (int j = 0; j < 8; ++j) { const f32x4 gg = gr[64 * j]; o[64 * j] = (f32x4){v[j].x * r * gg.x, v[j].y * r * gg.y, v[j].z * r * gg.z, v[j].w * r * gg.w}; }
    }
}

#ifndef MK_P2_VCU
#define MK_P2_VCU 0
#endif
#ifndef MK_P1_STAGGER
#define MK_P1_STAGGER 0
#endif
struct Args { Params p; int ph_lo, ph_hi; };
constexpr int N_PHASES = 10;

__global__ void __launch_bounds__(NTHREADS, 2) mk_fwd(Args args) {
    extern __shared__ __attribute__((aligned(16))) unsigned char lds_raw[];
    Frame F;
    F.lds = (LAS unsigned char*)lds_raw;
    F.tid = threadIdx.x; F.lane = F.tid & 63; F.wave = __builtin_amdgcn_readfirstlane(F.tid >> 6);
    F.G = gridDim.x; { const int bx = blockIdx.x; F.vcu = (F.G % 8 == 0) ? (bx % 8) * (F.G / 8) + bx / 8 : bx; }
    const Params& P = args.p;
    F.x = P.in[0]; F.norm1_g = P.in[1]; F.w_in = P.in[2]; F.lb_logits = P.in[3]; F.hg_norm_g = P.in[4]; F.gla_w2 = P.in[5]; F.gla_b = P.in[6]; F.gla_norm_g = P.in[7];
    F.w_proj_a = P.in[8]; F.w_proj_b = P.in[9]; F.w_out = P.in[10]; F.norm2_g = P.in[11]; F.router_w = P.in[12]; F.router_b = P.in[13]; F.w_gate_up = P.in[14];
    F.b_gate_up = P.in[15]; F.w_down = P.in[16]; F.b_down = P.in[17]; F.final_g = P.in[18];
    F.out = P.out; F.ws = P.ws; F.ctl = (unsigned*)(P.ws + WS_CTL);
    for (int u = F.tid; u < (LDS_BYTES - RING_BYTES) / 4; u += NTHREADS) ((LAS unsigned*)(F.lds + RING_BYTES))[u] = 0u;
    __syncthreads();
    const int lo = args.ph_lo, hi = args.ph_hi;
    const bool use_bar = (hi - lo) > 1;
    XcdBarrier bar; bar.bar = F.ctl + CW_BAR; bar.x = 0; bar.st = nullptr;
    if (use_bar) bar = xcd_barrier_post(F.ctl + CW_BAR, (volatile LAS unsigned*)(F.lds + LDS_XB));
#ifdef MK_ONLYMASK
#define IN(k) (((MK_ONLYMASK >> (k)) & 1) && lo <= (k) && (k) < hi)
#else
#define IN(k) (lo <= (k) && (k) < hi)
#endif
#define SEAM(k) do { if (IN(k) && IN((k) + 1)) xcd_barrier(bar); } while (0)
    const int c = (int)blockIdx.x;
    if (IN(0)) { p0_prologue(F); } SEAM(0);
    if (IN(1)) {
        p1_gates(F, F.vcu, F.G);
#if MK_FP8_MG
        constexpr int NT_F8 = in_tiles_f8(), NT_BF = 48 - NT_F8;
        { InSched S{WSP(bf16_t, WS_XN), WSP(bf16_t, WS_WINT), NTOK / 256, NT_BF, F.G, c, 2 * D, 0};
          typedef EpiInProjT<(MK_ROWS64 != 0) && (MK_G8 != 0) && !MK_FP8_VG> EpiInBf; EpiInBf E{WSP(bf16_t, WS_ZB), WSP(float, WS_LB), 0, WSP(unsigned char, WS_G8)};
#if MK_FP8 && MK_DN_FILL
          DownFill FL{F.w_down, WSP(unsigned char, WS_WDNT), 0, F.G * NWAVES, F.vcu * NWAVES + F.wave, F.lane};
          pg8::gemm_phase<EpiInBf, InSched, false, DownFill, pg8::NoKFill, false, (MK_EPI_RELAX & 1) != 0>(F.lds, 2 * D, S, E, FL); }
#else
          pg8::gemm_phase(F.lds, 2 * D, S, E); }
#endif
        { InSched S{F.ws + WS_XN8, F.ws + WS_WINT8 - (MK_FP8_VG ? (size_t)0 : (size_t)Z_MGA * D), NTOK / 256, NT_F8, F.G, c, D, 1};
          EpiInProj E{WSP(bf16_t, WS_ZB), WSP(float, WS_LB), 0, WSP(unsigned char, WS_G8)};
#if MK_FP8 && MK_DN_FILL
          DownFill FL{F.w_down, WSP(unsigned char, WS_WDNT), NT_BF / 4, F.G * NWAVES, F.vcu * NWAVES + F.wave, F.lane};
          pg8::gemm_phase<EpiInProj, InSched, true, DownFill, pg8::NoKFill, false, (MK_EPI_RELAX & 2) != 0>(F.lds, D, S, E, FL); }
#else
          pg8::gemm_phase<EpiInProj, InSched, true>(F.lds, D, S, E); }
#endif
#else
        DenseSched S{WSP(bf16_t, WS_XN), WSP(bf16_t, WS_WINT), NTOK / 256, NZ / 256, F.G, c, 2 * D};
        EpiInProj E{WSP(bf16_t, WS_ZB), WSP(float, WS_LB), 0, WSP(unsigned char, WS_G8)};
        pg8::gemm_phase(F.lds, 2 * D, S, E);
#endif
    } SEAM(1);
    if (IN(2)) { for (int item = MK_P2_VCU ? F.vcu : c; item < 256; item += F.G) recur_item(F, item); } SEAM(2);
    if (IN(3)) { p3_combine(F); } SEAM(3);
    if (IN(4)) {
        constexpr int PO_RB = MK_FP8_PO ? 1024 : 2048;
        MergeSched S{WSP(bf16_t, WS_YA), WSP(bf16_t, WS_WPAT), (long)(WS_YB - WS_YA), (long)(WS_WPBT - WS_WPAT), NTOK / 256, D / 256, F.G, c, PO_RB};
        EpiMerge E{WSP(bf16_t, WS_ZB), WSP(bf16_t, WS_MERGED), WSP(const unsigned char, WS_G8)};
#if 0
#elif MK_FP8 && MK_DN_FILL
        DownFill FL{F.w_down, WSP(unsigned char, WS_WDNT), 12, F.G * NWAVES, F.vcu * NWAVES + F.wave, F.lane};
        pg8::gemm_phase<EpiMerge, MergeSched, (MK_FP8_PO != 0), DownFill, pg8::NoKFill, false, (MK_EPI_RELAX & 4) != 0>(F.lds, PO_RB, S, E, FL);
#else
        pg8::gemm_phase(F.lds, 2048, S, E);
#endif
    } SEAM(4);
    if (IN(5)) {
        DenseSched S{WSP(bf16_t, WS_MERGED), WSP(bf16_t, WS_WOUTT), NTOK / 256, D / 256, F.G, c, MK_FP8_PO ? D : 2 * D};
        EpiMix E{WSP(bf16_t, WS_H1), F.x};
#if MK_FP8 && MK_DN_FILL && !MK_H1_BF16
        DownFill FL{F.w_down, WSP(unsigned char, WS_WDNT), 16, F.G * NWAVES, F.vcu * NWAVES + F.wave, F.lane};
        pg8::gemm_phase<EpiMix, DenseSched, (MK_FP8_PO != 0), DownFill, pg8::NoKFill, false, (MK_EPI_RELAX & 8) != 0>(F.lds, MK_FP8_PO ? D : 2 * D, S, E, FL);
#else
        pg8::gemm_phase(F.lds, 2 * D, S, E);
#endif
    } SEAM(5);
    if (IN(6)) { p6_router(F); } SEAM(6);
    if (IN(7) || IN(8) || IN(9)) build_tab(F);
    if (IN(7)) {
        GuSched S{(const bf16_t*)(F.ws + (MK_P6_XN ? WS_XN8 : WS_XN)), WSP(bf16_t, WS_WGUT), WSP(int, WS_ROWTOK), (const volatile LAS int*)(F.lds + LDS_TAB), F.lds, F.G, c, MOE_RB, F.tid};
        EpiGU E{WSP(bf16_t, WS_ACT), F.b_gate_up};
#if MK_FP8 && MK_DN_FILL && MK_DN_FILL_P7
        DownFill FL{F.w_down, WSP(unsigned char, WS_WDNT), MK_H1_BF16 ? 16 : 18, F.G * NWAVES, F.vcu * NWAVES + F.wave, F.lane};
        pg8::gemm_phase<EpiGU, GuSched, true, DownFill, pg8::NoKFill, (MK_HALF_TILES != 0), (MK_EPI_RELAX & 16) != 0>(F.lds, MOE_RB, S, E, FL);
#else
        pg8::gemm_phase<EpiGU, GuSched, (MK_FP8 != 0)>(F.lds, MOE_RB, S, E);
#endif
    } SEAM(7);
    if (IN(8)) {
        DownSched S{WSP(bf16_t, WS_ACT), WSP(bf16_t, WS_WDNT), (const volatile LAS int*)(F.lds + LDS_TAB), F.G, c, MOE_RB};
        EpiDown E{WSP(unsigned char, WS_YPAIR), F.b_down, WSP(float, WS_ROWW)};
        pg8::gemm_phase<EpiDown, DownSched, (MK_FP8 != 0), pg8::NoFill, pg8::NoKFill, (MK_HALF_TILES != 0) || (MK_TAIL_SPLIT != 0), (MK_EPI_RELAX & 32) != 0>(F.lds, MOE_RB, S, E);
    } SEAM(8);
    if (IN(9)) { p9_final(F); }
#undef IN
#undef SEAM
}


#ifndef MK_N_LAUNCHES
#define MK_N_LAUNCHES 1
#endif
static void mk_forward(void* const* d_in, void* d_out, void* d_ws, hipStream_t stream) {
    static int ready = 0;
    if (!ready) { (void)hipFuncSetAttribute((const void*)mk_fwd, hipFuncAttributeMaxDynamicSharedMemorySize, LDS_BYTES); ready = 1; }
    (void)hipMemsetAsync((char*)d_ws + WS_CTL, 0, CTL_ZERO_BYTES, stream);
#ifdef MK_NANFILL
    (void)hipMemsetAsync((char*)d_ws + CTL_ZERO_BYTES, 0xFF, WS_END - CTL_ZERO_BYTES, stream);
#endif
    Args a; __builtin_memset(&a, 0, sizeof(a));
    for (int i = 0; i < 19; ++i) a.p.in[i] = (const float*)d_in[i];
    a.p.out = (float*)d_out; a.p.ws = (unsigned char*)d_ws;
    const int grid = 256;
#if MK_N_LAUNCHES == 1
    a.ph_lo = 0; a.ph_hi = N_PHASES;
    hipLaunchKernelGGL(mk_fwd, dim3(grid), dim3(NTHREADS), LDS_BYTES, stream, a);
#else
#ifndef MK_REPEAT_MASK
#define MK_REPEAT_MASK 0
#endif
    for (int ph = 0; ph < N_PHASES; ++ph) { a.ph_lo = ph; a.ph_hi = ph + 1; const int reps = ((MK_REPEAT_MASK >> ph) & 1) ? 4 : 1;
        for (int r = 0; r < reps; ++r) hipLaunchKernelGGL(mk_fwd, dim3(grid), dim3(NTHREADS), LDS_BYTES, stream, a); }
#endif
}

extern "C" void kernel_launch(void* const* d_in, const int* in_sizes, int n_in, void* d_out, int out_size, void* d_ws, size_t ws_size, hipStream_t stream) {
    (void)in_sizes; (void)n_in; (void)out_size; (void)ws_size;
    mk_forward(d_in, d_out, d_ws, stream);
}
```
